# Optimizing an MI355X kernel written in HIP

```python
import math
import jax, jax.numpy as jnp
from jax import lax
import numpy as np

D_MODEL = 1024
BATCH = 8
SEQ = 2048
DEPTH = 2
DEC_BATCH = 128
DEC_SEQ = 1
PAST_LEN = 16384
PAGE_SIZE = 128

N_META = 16
D_INNER = 2 * D_MODEL
SSM_HEAD_DIM = 64
SSM_HEADS = D_INNER // SSM_HEAD_DIM
SSM_GROUPS = 4
SSM_HPG = SSM_HEADS // SSM_GROUPS
SSM_STATE = 128
CONV_K = 4
CONV_DIM = D_INNER + 2 * SSM_GROUPS * SSM_STATE
SSD_CHUNK = 128
RWKV_DIM = D_MODEL
RWKV_HEAD_DIM = 64
RWKV_HEADS = RWKV_DIM // RWKV_HEAD_DIM
DECAY_LORA = 64
AAA_LORA = 64
GATE_LORA = 128
RWKV_COLS = 3 * RWKV_DIM + DECAY_LORA + AAA_LORA + GATE_LORA
IN_SPLITS = (D_INNER, D_INNER + CONV_DIM, D_INNER + CONV_DIM + SSM_HEADS,
             D_INNER + CONV_DIM + SSM_HEADS + RWKV_COLS)
IN_COLS = IN_SPLITS[-1] + 2 * D_MODEL
RWKV_SPLITS = (RWKV_DIM, 2 * RWKV_DIM, 3 * RWKV_DIM, 3 * RWKV_DIM + DECAY_LORA,
               3 * RWKV_DIM + DECAY_LORA + AAA_LORA)
D_FF = -(-8 * D_MODEL // (3 * 256)) * 256
ALPHA = (2 * DEPTH) ** 0.25
BETA = (8 * DEPTH) ** -0.25
LN_EPS = 1e-5
RMS_EPS = 1e-5
GN_EPS = 64e-5
F32 = jnp.float32

kernel_name = 'hybrid_ssd_rwkv7_gated_decoder_step'


def layer_norm(x, g, b):
    xf = x.astype(F32)
    mu = jnp.mean(xf, axis=-1, keepdims=True)
    var = jnp.mean(jnp.square(xf - mu), axis=-1, keepdims=True)
    return ((xf - mu) * lax.rsqrt(var + LN_EPS)).astype(x.dtype) * g + b


def causal_conv(prefix, u, w, b):
    L = u.shape[1]
    full = jnp.concatenate([prefix.astype(u.dtype), u], axis=1)
    y = b + sum(full[:, k:k + L] * w[k] for k in range(CONV_K))
    return y, full[:, L:]


def ssd_segment(x, dt, a, bm, cm, h0):
    bsz, L = x.shape[:2]
    q = min(SSD_CHUNK, L)
    nc = -(-L // q)
    pad = nc * q - L
    if pad:
        padf = lambda t: jnp.pad(t, [(0, 0), (0, pad)] + [(0, 0)] * (t.ndim - 2))
        x, dt, bm, cm = padf(x), padf(dt), padf(bm), padf(cm)
    ch = lambda t: t.reshape((bsz, nc, q) + t.shape[2:])
    x, dt, bm, cm = ch(x), ch(dt), ch(bm), ch(cm)
    acum = jnp.cumsum((dt * a).astype(F32), axis=2)
    causal = jnp.tril(jnp.ones((q, q), dtype=bool))
    diff = acum[:, :, :, None] - acum[:, :, None, :]
    lmat = jnp.exp(jnp.where(causal[:, :, None, None], diff, -jnp.inf))
    xdt = x * dt[..., None]
    cb = jnp.einsum('bcign,bcjgn->bcijg', cm, bm)
    y_diag = jnp.einsum('bcijg,bcijgr,bcjgrp->bcigrp', cb, lmat, xdt)
    decay_to_end = jnp.exp(acum[:, :, -1:] - acum)
    chunk_states = jnp.einsum('bcjgn,bcjgr,bcjgrp->bcgrpn', bm, decay_to_end, xdt)
    chunk_decay = jnp.exp(acum[:, :, -1])

    def step(h, inp):
        s, d = inp
        return h * d[..., None, None] + s, h

    h_final, h_starts = lax.scan(step, h0.astype(F32),
                                 (jnp.moveaxis(chunk_states, 1, 0), jnp.moveaxis(chunk_decay, 1, 0)))
    h_starts = jnp.moveaxis(h_starts, 0, 1)
    y_off = jnp.einsum('bcign,bcgrpn,bcigr->bcigrp', cm, h_starts, jnp.exp(acum))
    y = (y_diag + y_off).reshape((bsz, nc * q) + x.shape[3:])[:, :L]
    return y, h_final


def mamba_branch(u_z, u_xbc, u_dt, h0, conv_prefix, segments, lw):
    bsz, L = u_z.shape[:2]
    xbc, conv_tail = causal_conv(conv_prefix, u_xbc, lw['conv_w'], lw['conv_b'])
    xbc = jax.nn.silu(xbc)
    xs, bm, cm = jnp.split(xbc, [D_INNER, D_INNER + SSM_GROUPS * SSM_STATE], axis=-1)
    xs = xs.reshape(bsz, L, SSM_GROUPS, SSM_HPG, SSM_HEAD_DIM)
    bm = bm.reshape(bsz, L, SSM_GROUPS, SSM_STATE)
    cm = cm.reshape(bsz, L, SSM_GROUPS, SSM_STATE)
    dt = jax.nn.softplus(u_dt.astype(F32) + lw['dt_bias']).reshape(bsz, L, SSM_GROUPS, SSM_HPG)
    a = -jnp.exp(lw['a_log'].astype(F32)).reshape(SSM_GROUPS, SSM_HPG)
    h = h0.reshape(bsz, SSM_GROUPS, SSM_HPG, SSM_HEAD_DIM, SSM_STATE)
    ys = []
    start = 0
    for seg in segments:
        sl = slice(start, start + seg)
        y_seg, h = ssd_segment(xs[:, sl], dt[:, sl], a, bm[:, sl], cm[:, sl], h)
        ys.append(y_seg)
        start += seg
    y = jnp.concatenate(ys, axis=1) if len(ys) > 1 else ys[0]
    y = y + xs * lw['d_skip'].reshape(SSM_GROUPS, SSM_HPG, 1)
    y = y.reshape(bsz, L, D_INNER) * jax.nn.silu(u_z)
    yg = y.reshape(bsz, L, SSM_GROUPS, D_INNER // SSM_GROUPS).astype(F32)
    yg = yg * lax.rsqrt(jnp.mean(jnp.square(yg), axis=-1, keepdims=True) + RMS_EPS)
    y = yg.reshape(bsz, L, D_INNER).astype(u_z.dtype) * lw['ssm_norm_w']
    return y, h.reshape(bsz, SSM_HEADS, SSM_HEAD_DIM, SSM_STATE), conv_tail


def rwkv_branch(u_r, shift_prev, s0, lw):
    bsz, L = u_r.shape[:2]
    prev = jnp.concatenate([shift_prev[:, None].astype(u_r.dtype), u_r[:, :-1]], axis=1)
    shifted = u_r + (prev - u_r) * lw['shift_mu']
    r, k, v, w_lo, a_lo, g_lo = jnp.split(shifted, RWKV_SPLITS, axis=-1)
    w_log = -jax.nn.softplus(-(lw['w0'] + jnp.tanh(w_lo) @ lw['w_lora_up'])) - 0.5
    decay = jnp.exp(-jnp.exp(w_log.astype(F32)))
    a = jax.nn.sigmoid(lw['a0'] + a_lo @ lw['a_lora_up'])
    g = jax.nn.sigmoid(g_lo) @ lw['g_lora_up']
    hd = lambda t: t.reshape(bsz, L, RWKV_HEADS, RWKV_HEAD_DIM).astype(F32)
    kk = hd(k * lw['k_k'])
    kk = kk * lax.rsqrt(jnp.maximum(jnp.sum(kk * kk, axis=-1, keepdims=True), 1e-24))
    k_mod = k * (1 + (a - 1) * lw['k_a'])
    r_h, k_h, v_h, w_h, a_h = hd(r), hd(k_mod), hd(v), hd(decay), hd(a)

    def step(S, inp):
        r_t, w_t, k_t, v_t, kk_t, a_t = inp
        sa = jnp.einsum('bhij,bhj->bhi', S, -kk_t)
        S = (S * w_t[:, :, None, :] + sa[..., None] * (kk_t * a_t)[:, :, None, :]
             + v_t[..., None] * k_t[:, :, None, :])
        return S, jnp.einsum('bhij,bhj->bhi', S, r_t)

    tm = lambda t: jnp.moveaxis(t, 1, 0)
    s_fin, o = lax.scan(step, s0.astype(F32), (tm(r_h), tm(w_h), tm(k_h), tm(v_h), tm(kk), tm(a_h)))
    o = jnp.moveaxis(o, 0, 1)
    mu = jnp.mean(o, axis=-1, keepdims=True)
    var = jnp.mean(jnp.square(o - mu), axis=-1, keepdims=True)
    on = ((o - mu) * lax.rsqrt(var + GN_EPS)).reshape(bsz, L, RWKV_DIM) * lw['lnx_g'] + lw['lnx_b']
    bonus = jnp.sum(r_h * k_h * lw['r_k'], axis=-1, keepdims=True) * v_h
    out = (on + bonus.reshape(bsz, L, RWKV_DIM)) * g
    return out, s_fin, u_r[:, -1]


def decoder_layer(x, h0, conv_prefix, s0, shift_prev, segments, lw):
    u = jnp.einsum('bld,de->ble', x, lw['w_in'])
    u_z, u_xbc, u_dt, u_r, u_gate = jnp.split(u, IN_SPLITS, axis=-1)
    y_ssm, h_new, conv_new = mamba_branch(u_z, u_xbc, u_dt, h0, conv_prefix, segments, lw)
    y_rwkv, s_new, shift_new = rwkv_branch(u_r, shift_prev, s0, lw)
    gate_ssm, gate_rwkv = jnp.split(jax.nn.sigmoid(u_gate), 2, axis=-1)
    merged = gate_ssm * (y_ssm @ lw['p_ssm']) + gate_rwkv * (y_rwkv @ lw['p_rwkv'])
    x = layer_norm(ALPHA * x + merged @ lw['w_out'], lw['ln1_g'], lw['ln1_b'])
    hg, hu = jnp.split(x @ lw['w_ffn_in'], 2, axis=-1)
    x = layer_norm(ALPHA * x + (jax.nn.silu(hg) * hu) @ lw['w_ffn_out'], lw['ln2_g'], lw['ln2_b'])
    return x, h_new, conv_new, s_new, shift_new


def run_trunk(x, ssm0, conv0, wkv0, shift0, segments, weights):
    ssm_l, conv_l, wkv_l, shift_l = [], [], [], []
    for l in range(DEPTH):
        lw = {name: arr[l] for name, arr in weights.items()}
        x, h, c, s, sh = decoder_layer(x, ssm0[l], conv0[l], wkv0[l], shift0[l], segments, lw)
        ssm_l.append(h)
        conv_l.append(c)
        wkv_l.append(s)
        shift_l.append(sh)
    return x, jnp.stack(ssm_l), jnp.stack(conv_l), jnp.stack(wkv_l), jnp.stack(shift_l)


def setup_inputs(seed: int = 0) -> dict:
    key = jax.random.key(seed)
    ks = iter(jax.random.split(key, 48))
    nrm = lambda shape, scale: scale * jax.random.normal(next(ks), shape, F32)
    unif = lambda shape, lo, hi: jax.random.uniform(next(ks), shape, F32, lo, hi)
    dt_init = jnp.exp(unif((DEPTH, SSM_HEADS), math.log(1e-3), math.log(1e-1)))
    return {
        'x_prompt': nrm((BATCH, SEQ, D_MODEL), 1.0),
        'x_sample': nrm((DEC_BATCH, DEC_SEQ, D_MODEL), 1.0),
        'state_ssm': nrm((DEPTH, DEC_BATCH, SSM_HEADS, SSM_HEAD_DIM, SSM_STATE), 0.5),
        'state_conv': nrm((DEPTH, DEC_BATCH, CONV_K - 1, CONV_DIM), 1.0),
        'state_wkv': nrm((DEPTH, DEC_BATCH, RWKV_HEADS, RWKV_HEAD_DIM, RWKV_HEAD_DIM), 0.3),
        'state_shift': nrm((DEPTH, DEC_BATCH, RWKV_COLS), 1.0),
        'meta_tokens': nrm((N_META, D_MODEL), 1.0),
        'w_in': nrm((DEPTH, D_MODEL, IN_COLS), D_MODEL ** -0.5),
        'conv_w': nrm((DEPTH, CONV_K, CONV_DIM), CONV_K ** -0.5),
        'conv_b': nrm((DEPTH, CONV_DIM), 0.01),
        'dt_bias': dt_init + jnp.log(-jnp.expm1(-dt_init)),
        'a_log': jnp.log(unif((DEPTH, SSM_HEADS), 1.0, 16.0)),
        'd_skip': 1.0 + nrm((DEPTH, SSM_HEADS), 0.1),
        'ssm_norm_w': 1.0 + nrm((DEPTH, D_INNER), 0.02),
        'p_ssm': nrm((DEPTH, D_INNER, D_MODEL), D_INNER ** -0.5),
        'shift_mu': unif((DEPTH, RWKV_COLS), 0.0, 1.0),
        'w0': unif((DEPTH, RWKV_DIM), -6.0, 0.0),
        'w_lora_up': nrm((DEPTH, DECAY_LORA, RWKV_DIM), 0.5 * DECAY_LORA ** -0.5),
        'a0': nrm((DEPTH, RWKV_DIM), 0.1),
        'a_lora_up': nrm((DEPTH, AAA_LORA, RWKV_DIM), AAA_LORA ** -0.5),
        'g_lora_up': nrm((DEPTH, GATE_LORA, RWKV_DIM), GATE_LORA ** -0.5),
        'k_k': 0.85 + nrm((DEPTH, RWKV_DIM), 0.05),
        'k_a': 1.0 + nrm((DEPTH, RWKV_DIM), 0.05),
        'r_k': nrm((DEPTH, RWKV_HEADS, RWKV_HEAD_DIM), 0.1),
        'lnx_g': 1.0 + nrm((DEPTH, RWKV_DIM), 0.02),
        'lnx_b': nrm((DEPTH, RWKV_DIM), 0.01),
        'p_rwkv': nrm((DEPTH, RWKV_DIM, D_MODEL), RWKV_DIM ** -0.5),
        'w_out': nrm((DEPTH, D_MODEL, D_MODEL), BETA * D_MODEL ** -0.5),
        'ln1_g': 1.0 + nrm((DEPTH, D_MODEL), 0.02),
        'ln1_b': nrm((DEPTH, D_MODEL), 0.01),
        'w_ffn_in': nrm((DEPTH, D_MODEL, 2 * D_FF), D_MODEL ** -0.5),
        'w_ffn_out': nrm((DEPTH, D_FF, D_MODEL), BETA * D_FF ** -0.5),
        'ln2_g': 1.0 + nrm((DEPTH, D_MODEL), 0.02),
        'ln2_b': nrm((DEPTH, D_MODEL), 0.01),
    }


def reference(x_prompt, x_sample, state_ssm, state_conv, state_wkv, state_shift, meta_tokens,
              w_in, conv_w, conv_b, dt_bias, a_log, d_skip, ssm_norm_w, p_ssm, shift_mu,
              w0, w_lora_up, a0, a_lora_up, g_lora_up, k_k, k_a, r_k, lnx_g, lnx_b, p_rwkv,
              w_out, ln1_g, ln1_b, w_ffn_in, w_ffn_out, ln2_g, ln2_b):
    weights = {
        'w_in': w_in, 'conv_w': conv_w, 'conv_b': conv_b, 'dt_bias': dt_bias, 'a_log': a_log,
        'd_skip': d_skip, 'ssm_norm_w': ssm_norm_w, 'p_ssm': p_ssm, 'shift_mu': shift_mu,
        'w0': w0, 'w_lora_up': w_lora_up, 'a0': a0, 'a_lora_up': a_lora_up, 'g_lora_up': g_lora_up,
        'k_k': k_k, 'k_a': k_a, 'r_k': r_k, 'lnx_g': lnx_g, 'lnx_b': lnx_b, 'p_rwkv': p_rwkv,
        'w_out': w_out, 'ln1_g': ln1_g, 'ln1_b': ln1_b, 'w_ffn_in': w_ffn_in,
        'w_ffn_out': w_ffn_out, 'ln2_g': ln2_g, 'ln2_b': ln2_b,
    }
    bsz, seq = x_prompt.shape[:2]
    meta = jnp.broadcast_to(meta_tokens.astype(x_prompt.dtype)[None], (bsz, N_META, D_MODEL))
    xp = jnp.concatenate([meta, x_prompt], axis=1)
    ssm0 = jnp.zeros((DEPTH, bsz, SSM_HEADS, SSM_HEAD_DIM, SSM_STATE), F32)
    conv0 = jnp.zeros((DEPTH, bsz, CONV_K - 1, CONV_DIM), x_prompt.dtype)
    wkv0 = jnp.zeros((DEPTH, bsz, RWKV_HEADS, RWKV_HEAD_DIM, RWKV_HEAD_DIM), F32)
    shift0 = jnp.zeros((DEPTH, bsz, RWKV_COLS), x_prompt.dtype)
    yp, ssm_p, conv_p, wkv_p, shift_p = run_trunk(xp, ssm0, conv0, wkv0, shift0, (N_META, seq), weights)
    y_prompt = yp[:, N_META:]
    y_sample, ssm_s, conv_s, wkv_s, shift_s = run_trunk(
        x_sample, state_ssm, state_conv, state_wkv, state_shift, (x_sample.shape[1],), weights)
    return (y_prompt, y_sample, ssm_p, conv_p, wkv_p, shift_p, ssm_s, conv_s, wkv_s, shift_s)
```

```cpp
#include <hip/hip_runtime.h>
#include <hip/hip_cooperative_groups.h>
#include <cstdio>
namespace cg = cooperative_groups;

__device__ __forceinline__ int ltid() { int t = threadIdx.x; asm volatile("" : "+v"(t)); return t; }
__device__ __forceinline__ int lbid() { int t = blockIdx.x; asm volatile("" : "+s"(t)); return t; }
__device__ __forceinline__ int lgdim() { int t = gridDim.x; asm volatile("" : "+s"(t)); return t; }
namespace pg8 {
#define PG8_LAS __attribute__((address_space(3)))
typedef unsigned short bf16_t;
typedef short bf16x8 __attribute__((ext_vector_type(8)));
typedef float f32x4 __attribute__((ext_vector_type(4)));
typedef unsigned u32x4 __attribute__((ext_vector_type(4)));
constexpr int BM = 256, BK = 64, HALF = 128, HTB = HALF * BK * 2  , STAGE_BYTES = 8 * HTB, NXCD = 8, WGM = 8;

__host__ __device__ __forceinline__ int lds_byte(int r, int c) { const int st = (r >> 4) * 2 + (c >> 5), rr = r & 15, cc = c & 31, ob = rr * 64 + cc * 2; return st * 1024 + (ob ^ (((ob >> 9) & 1) << 5)); }
__host__ __device__ __forceinline__ void stage_rc(int b, int& R, int& C) { const int st = b / 1024, sb = b % 1024, swz = sb ^ (((sb >> 9) & 1) << 5); R = (st >> 1) * 16 + swz / 64; C = (st & 1) * 32 + (swz % 64) / 2; }
__host__ __device__ __forceinline__ int perm32(int rho) { const int n = rho >> 4, i = rho & 15; return 8 * (i >> 2) + 4 * n + (i & 3); }

struct Unit { int pm, pn; };
struct Gemm { const bf16_t* A; const bf16_t* Bt; int M, N, K; int lda; };

struct StaticOrder {
    int nM, nN, nwg, G, c;
    __host__ __device__ void init(int M, int N, int G_, int c_) { nM = M / BM; nN = N / BM; nwg = nM * nN; G = G_; c = c_; }
    __host__ __device__ bool next(int i, Unit& u) const {
        const long L = (long)i * G + c; if (L >= nwg) return false;
        int wgid = (int)L; { const int q = nwg / NXCD, r = nwg % NXCD, xcd = wgid % NXCD, off = wgid / NXCD; wgid = (xcd < r ? xcd * (q + 1) : r * (q + 1) + (xcd - r) * q) + off; }
        const int nig = WGM * nN, gid = wgid / nig, fm = gid * WGM, gsz = (nM - fm) < WGM ? (nM - fm) : WGM;
        u.pm = fm + ((wgid % nig) % gsz); u.pn = (wgid % nig) / gsz; return true;
    }
    __device__ __forceinline__ void a_ready(const Unit&) const {}
    __device__ __forceinline__ void done(const Unit&) const {}
};
__device__ __forceinline__ unsigned cvt_pk_bf16(float lo, float hi) { unsigned r; asm volatile("v_cvt_pk_bf16_f32 %0, %1, %2" : "=v"(r) : "v"(lo), "v"(hi)); return r; }
template <class Epi, class Sched>
__device__ __forceinline__ void gemm_phase(PG8_LAS unsigned char* lds, const Gemm g, const Sched& S, const Epi& E) {
    const int tid = ltid(), wid = __builtin_amdgcn_readfirstlane(tid >> 6), lane = tid & 63, wr = wid >> 2, wc = wid & 3, fr = lane & 15, fq = lane >> 4;
    const int K = g.K, nt = K / BK;
    unsigned voffA[2], voffB[2];
#pragma unroll
    for (int i = 0; i < 2; ++i) { int R, C; stage_rc(tid * 16 + i * 8192, R, C); const int Rb = Epi::PERM ? ((R & ~31) + perm32(R & 31)) : R;
        voffA[i] = (unsigned)(R * g.lda + C) * 2u; voffB[i] = (unsigned)(Rb * K + C) * 2u; }
    const size_t kstep = (size_t)(BK * 2);
    const size_t hstep = (size_t)HALF * K * 2;
    const size_t tstep = 2 * hstep;
    const size_t hstepA = (size_t)HALF * g.lda * 2, tstepA = 2 * hstepA;
    const unsigned ldsw = (unsigned)wid * 1024u;
    const int aoff = lds_byte(wr * 64 + fr, fq * 8), boff = lds_byte(wc * 32 + fr, fq * 8);
#define PG8_SA(b, h) (((b) * 2 + (h)) * HTB)
#define PG8_SB(b, h) ((4 + (b) * 2 + (h)) * HTB)
#define PG8_STAGE(bufoff, gbase, voff) do { _Pragma("unroll") for (int _i = 0; _i < 2; ++_i) \
        __builtin_amdgcn_global_load_lds((const unsigned*)((const char*)(gbase) + (voff)[_i]), (PG8_LAS unsigned*)(lds + (bufoff) + ldsw + _i * 8192), 16, 0, 0); } while (0)
#define PG8_LDA(dst, b, h) do { _Pragma("unroll") for (int m = 0; m < 4; ++m) _Pragma("unroll") for (int k = 0; k < 2; ++k) dst[m][k] = *(const PG8_LAS bf16x8*)(lds + PG8_SA(b, h) + aoff + m * 2048 + k * 1024); } while (0)
#define PG8_LDB(dst, b, h) do { _Pragma("unroll") for (int n = 0; n < 2; ++n) _Pragma("unroll") for (int k = 0; k < 2; ++k) dst[n][k] = *(const PG8_LAS bf16x8*)(lds + PG8_SB(b, h) + boff + n * 2048 + k * 1024); } while (0)
#define PG8_MMA(ai, bj, At, Bt) do { __builtin_amdgcn_s_setprio(1); _Pragma("unroll") for (int m = 0; m < 4; ++m) _Pragma("unroll") for (int n = 0; n < 2; ++n) _Pragma("unroll") for (int k = 0; k < 2; ++k) \
        acc[ai][bj][m][n] = __builtin_amdgcn_mfma_f32_16x16x32_bf16(Bt[n][k], At[m][k], acc[ai][bj][m][n], 0, 0, 0); __builtin_amdgcn_s_setprio(0); } while (0)
#define PG8_WAIT_V(n) asm volatile("s_waitcnt vmcnt(" #n ")" ::: "memory")
#define PG8_WAIT_L(n) asm volatile("s_waitcnt lgkmcnt(" #n ")" ::: "memory")
#define PG8_BAR __builtin_amdgcn_s_barrier()
#define PG8_SCHED __builtin_amdgcn_sched_barrier(0)
    Unit cur, nxt; int ui = 0;
    if (!S.next(0, cur)) return;
    f32x4 acc[2][2][4][2];
#pragma unroll
    for (int a = 0; a < 2; ++a)
#pragma unroll
        for (int b = 0; b < 2; ++b)
#pragma unroll
            for (int m = 0; m < 4; ++m)
#pragma unroll
                for (int n = 0; n < 2; ++n) acc[a][b][m][n] = (f32x4){0.f, 0.f, 0.f, 0.f};
    bf16x8 At[4][2], B0[2][2], B1[2][2];
    const char* cA = (const char*)g.A + (size_t)cur.pm * tstepA; const char* cB = (const char*)g.Bt + (size_t)cur.pn * tstep;
    S.a_ready(cur);
    PG8_STAGE(PG8_SB(0, 0), cB, voffB); PG8_STAGE(PG8_SA(0, 0), cA, voffA); PG8_STAGE(PG8_SB(0, 1), cB + hstep, voffB); PG8_STAGE(PG8_SA(0, 1), cA + hstepA, voffA);
    if (wr == 1) PG8_BAR;
    PG8_WAIT_V(4); PG8_BAR;
    PG8_STAGE(PG8_SB(1, 0), cB + kstep, voffB); PG8_STAGE(PG8_SA(1, 0), cA + kstep, voffA); PG8_STAGE(PG8_SB(1, 1), cB + hstep + kstep, voffB);
    PG8_WAIT_V(6); PG8_BAR;
    for (;;) {
        const bool has_next = S.next(ui + 1, nxt);
        const char* nA = has_next ? (const char*)g.A + (size_t)nxt.pm * tstepA : cA; const char* nB = has_next ? (const char*)g.Bt + (size_t)nxt.pn * tstep : cB;
        for (int t = 0; t < nt; t += 2) {
            const bool last = (t == nt - 2);
            const char* a1 = cA + (size_t)(t + 1) * kstep;
            const char* a2 = last ? nA : cA + (size_t)(t + 2) * kstep; const char* b2 = last ? nB : cB + (size_t)(t + 2) * kstep;
            const char* a3 = a2 + kstep; const char* b3 = b2 + kstep;
            if (last && has_next) S.a_ready(nxt);
            PG8_LDB(B0, 0, 0); PG8_SCHED; PG8_LDA(At, 0, 0); PG8_STAGE(PG8_SA(1, 1), a1 + hstepA, voffA);
            PG8_WAIT_L(8); PG8_BAR; PG8_WAIT_L(0); PG8_MMA(0, 0, At, B0); PG8_BAR; PG8_SCHED;
            PG8_LDB(B1, 0, 1); PG8_STAGE(PG8_SB(0, 0), b2, voffB);
            PG8_BAR; PG8_WAIT_L(0); PG8_MMA(0, 1, At, B1); PG8_BAR;
            PG8_LDA(At, 0, 1); PG8_STAGE(PG8_SA(0, 0), a2, voffA);
            PG8_BAR; PG8_WAIT_L(0); PG8_MMA(1, 0, At, B0); PG8_BAR; PG8_SCHED;
            PG8_STAGE(PG8_SB(0, 1), b2 + hstep, voffB);
            PG8_WAIT_V(6); PG8_BAR; PG8_MMA(1, 1, At, B1); PG8_BAR;
            PG8_LDB(B0, 1, 0); PG8_SCHED; PG8_LDA(At, 1, 0); PG8_STAGE(PG8_SA(0, 1), a2 + hstepA, voffA);
            PG8_WAIT_L(8); PG8_BAR; PG8_WAIT_L(0); PG8_MMA(0, 0, At, B0); PG8_BAR; PG8_SCHED;
            PG8_LDB(B1, 1, 1); PG8_STAGE(PG8_SB(1, 0), b3, voffB);
            PG8_BAR; PG8_WAIT_L(0); PG8_MMA(0, 1, At, B1); PG8_BAR;
            PG8_LDA(At, 1, 1); PG8_STAGE(PG8_SA(1, 0), a3, voffA);
            PG8_BAR; PG8_WAIT_L(0); PG8_MMA(1, 0, At, B0); PG8_BAR; PG8_SCHED;
            PG8_STAGE(PG8_SB(1, 1), b3 + hstep, voffB);
            PG8_WAIT_V(6); PG8_BAR; PG8_MMA(1, 1, At, B1); PG8_BAR;
        }
        if constexpr (!Epi::AFTER_DRAIN) { E(acc, cur, wr, wc, fr, fq); S.done(cur); }
        if (!has_next) break;
#pragma unroll
        for (int a = 0; a < 2; ++a)
#pragma unroll
            for (int b = 0; b < 2; ++b)
#pragma unroll
                for (int m = 0; m < 4; ++m)
#pragma unroll
                    for (int n = 0; n < 2; ++n) acc[a][b][m][n] = (f32x4){0.f, 0.f, 0.f, 0.f};
        cur = nxt; cA = nA; cB = nB; ++ui;
    }
    PG8_WAIT_V(0);
    if (wr == 0) PG8_BAR;
    PG8_BAR;
    if constexpr (Epi::AFTER_DRAIN) { E.fused(acc, cur, wr, wc, fr, fq, lds, wid, lane); S.done(cur); }
#undef PG8_SA
#undef PG8_SB
#undef PG8_STAGE
#undef PG8_LDA
#undef PG8_LDB
#undef PG8_MMA
#undef PG8_WAIT_V
#undef PG8_WAIT_L
#undef PG8_BAR
#undef PG8_SCHED
}
}

typedef unsigned short bf16_t;
using pg8::f32x4; using pg8::bf16x8; using pg8::u32x4; using pg8::Unit;
typedef unsigned u32x2 __attribute__((ext_vector_type(2)));
typedef float f32x2 __attribute__((ext_vector_type(2)));
#define LAS __attribute__((address_space(3)))
constexpr int DM = 1024, NB = 8, SEQ = 2048, NMETA = 16, LP = SEQ + NMETA, MP = NB * LP, NS = 128, MT = MP + NS;
constexpr int DI = 2048, NH = 32, CD = 3072, RC = 3328, NIN = 10528, NP = 10752, DFF = 2816, NLORA = 3072, KLORA = 256;
constexpr int C_X = 2048, C_DT = 5120, C_R = 5152, C_GS = 8480, C_GR = 9504;
constexpr float ALPHA = 1.4142135623730951f;
constexpr size_t MiB = 1u << 20;
constexpr size_t W_IN = 0, W_PS = 21 * MiB, W_PR = 25 * MiB, W_WO = 27 * MiB, W_FI = 29 * MiB, W_FO = 40 * MiB, W_LR = 46 * MiB, W_STRIDE = 48 * MiB;
constexpr size_t OFF_U = 96 * MiB, OFF_X = 438 * MiB, OFF_XB = 503 * MiB, OFF_LOR = 536 * MiB, OFF_T = OFF_LOR, OFF_X1B = OFF_LOR + 66 * MiB;
constexpr size_t OFF_O = 731 * MiB, OFF_MG = OFF_LOR + 33 * MiB, OFF_AP = 927 * MiB, OFF_DT = 936 * MiB, OFF_SSQ = 944 * MiB  , OFF_BON = 940 * MiB, OFF_ACT = OFF_U;
constexpr size_t OFF_BAR = 943 * MiB;
constexpr size_t OUT_YP = 0, OUT_YSM = OUT_YP + (size_t)NB * SEQ * DM, OUT_SSMP = OUT_YSM + (size_t)NS * DM, OUT_CONVP = OUT_SSMP + (size_t)2 * NB * NH * 64 * 128,
    OUT_WKVP = OUT_CONVP + (size_t)2 * NB * 3 * CD, OUT_SHP = OUT_WKVP + (size_t)2 * NB * 16 * 64 * 64, OUT_SSMS = OUT_SHP + (size_t)2 * NB * RC,
    OUT_CONVS = OUT_SSMS + (size_t)2 * NS * NH * 64 * 128, OUT_WKVS = OUT_CONVS + (size_t)2 * NS * 3 * CD, OUT_SHS = OUT_WKVS + (size_t)2 * NS * 16 * 64 * 64;
enum { I_XP = 0, I_XS, I_SSSM, I_SCONV, I_SWKV, I_SSHIFT, I_META, I_WIN, I_CONVW, I_CONVB, I_DTB, I_ALOG, I_DSKIP, I_SNW, I_PSSM, I_MU, I_W0, I_WLU, I_A0, I_ALU, I_GLU,
       I_KK, I_KA, I_RK, I_LNXG, I_LNXB, I_PRWKV, I_WOUT, I_LN1G, I_LN1B, I_WFI, I_WFO, I_LN2G, I_LN2B, N_IN };
struct Params { const float* in[N_IN]; float* out; unsigned char* ws; };

__device__ __forceinline__ float bf2f(bf16_t h) { return __uint_as_float(((unsigned)h) << 16); }
__device__ __forceinline__ bf16_t f2bf(float f) { unsigned u = __float_as_uint(f); u += 0x7FFFu + ((u >> 16) & 1u); return (bf16_t)(u >> 16); }
__device__ __forceinline__ float sigm(float x) { return 1.f / (1.f + __expf(-x)); }
__device__ __forceinline__ float siluf(float x) { return x / (1.f + __expf(-x)); }
__device__ __forceinline__ float softplusf(float x) { return fmaxf(x, 0.f) + log1pf(__expf(-fabsf(x))); }
__device__ __forceinline__ unsigned pk2(float a, float b) { return pg8::cvt_pk_bf16(a, b); }
#define UNPACK8(v, f) do { f[0] = __uint_as_float((v).x << 16); f[1] = __uint_as_float((v).x & 0xffff0000u); f[2] = __uint_as_float((v).y << 16); f[3] = __uint_as_float((v).y & 0xffff0000u); \
    f[4] = __uint_as_float((v).z << 16); f[5] = __uint_as_float((v).z & 0xffff0000u); f[6] = __uint_as_float((v).w << 16); f[7] = __uint_as_float((v).w & 0xffff0000u); } while (0)
#define PACK8(f) (u32x4){pk2(f[0], f[1]), pk2(f[2], f[3]), pk2(f[4], f[5]), pk2(f[6], f[7])}
__device__ __forceinline__ float dpp_x1(float x) { return __int_as_float(__builtin_amdgcn_update_dpp(0, __float_as_int(x), 0xB1, 0xF, 0xF, true)); }
__device__ __forceinline__ float dpp_x2(float x) { return __int_as_float(__builtin_amdgcn_update_dpp(0, __float_as_int(x), 0x4E, 0xF, 0xF, true)); }
__device__ __forceinline__ float dpp_hm(float x) { return __int_as_float(__builtin_amdgcn_update_dpp(0, __float_as_int(x), 0x141, 0xF, 0xF, true)); }
__device__ __forceinline__ float red8(float x) { x += dpp_x1(x); x += dpp_x2(x); x += dpp_hm(x); return x; }

__device__ __forceinline__ float red16(float x) { x = red8(x); x += __int_as_float(__builtin_amdgcn_update_dpp(0, __float_as_int(x), 0x140, 0xF, 0xF, true)); return x; }
__device__ __forceinline__ float prev_rc(const Params& p, const bf16_t* U, int l, int m, int rc) {
    if (m < MP) { const int t = m % LP; return t ? bf2f(U[(size_t)(m - 1) * NP + C_R + rc]) : 0.f; }
    return p.in[I_SSHIFT][((size_t)l * NS + (m - MP)) * RC + rc];
}

__device__ __forceinline__ void transpose_cvt(const float* __restrict__ src, int ldsrc, int K, bf16_t* __restrict__ dst, int Nd, int nvalid, int mode, float* tile, int& toff) {
    const int tid = ltid(), ntn = Nd / 256, ntk = K / 64, G = lgdim(), nt = ntn * ntk;
    for (int t = (lbid() + G - toff % G) % G; t < nt; t += G) {
        const int tn = t % ntn, tk = t / ntn, n0 = tn * 256, k0 = tk * 64;
        { const int n4 = tid & 63, kk = tid >> 6, r = n0 + n4 * 4; int col;
          if (mode == 0) col = r < nvalid ? r : -1; else { const int pn = r >> 8, hf = (r >> 7) & 1, c = r & 127; col = hf * DFF + pn * 128 + c; }
          f32x4 v[8];
#pragma unroll
          for (int ps = 0; ps < 8; ++ps) v[ps] = col >= 0 ? __builtin_nontemporal_load((const f32x4*)(src + (size_t)(k0 + ps * 8 + kk) * ldsrc + col)) : (f32x4){0.f, 0.f, 0.f, 0.f};
#pragma unroll
          for (int ps = 0; ps < 8; ++ps) *(f32x4*)(tile + (ps * 8 + kk) * 260 + n4 * 4) = v[ps]; }
        __syncthreads();
        { const int n = tid >> 1, kh = tid & 1;
#pragma unroll
          for (int q = 0; q < 4; ++q) { float v[8];
#pragma unroll
              for (int j = 0; j < 8; ++j) v[j] = tile[(kh * 32 + q * 8 + j) * 260 + n];
              *(u32x4*)(dst + (size_t)(n0 + n) * K + k0 + kh * 32 + q * 8) = PACK8(v); } }
        __syncthreads();
    }
    toff += nt;
}
__device__ __forceinline__ void phase0(const Params& p, unsigned char* smem) {
    float* tile = (float*)smem; unsigned char* ws = p.ws; const int tid = ltid(); int toff = 0;
    for (int l = 0; l < 2; ++l) {
        unsigned char* wl = ws + (size_t)l * W_STRIDE;
        transpose_cvt(p.in[I_WIN] + (size_t)l * DM * NIN, NIN, DM, (bf16_t*)(wl + W_IN), NP, NIN, 0, tile, toff);
        transpose_cvt(p.in[I_PSSM] + (size_t)l * DI * DM, DM, DI, (bf16_t*)(wl + W_PS), DM, DM, 0, tile, toff);
        transpose_cvt(p.in[I_PRWKV] + (size_t)l * DM * DM, DM, DM, (bf16_t*)(wl + W_PR), DM, DM, 0, tile, toff);
        transpose_cvt(p.in[I_WOUT] + (size_t)l * DM * DM, DM, DM, (bf16_t*)(wl + W_WO), DM, DM, 0, tile, toff);
        transpose_cvt(p.in[I_WFI] + (size_t)l * DM * 2 * DFF, 2 * DFF, DM, (bf16_t*)(wl + W_FI), 2 * DFF, 2 * DFF, 1, tile, toff);
        transpose_cvt(p.in[I_WFO] + (size_t)l * DFF * DM, DM, DFF, (bf16_t*)(wl + W_FO), DM, DM, 0, tile, toff);
        bf16_t* wlr = (bf16_t*)(wl + W_LR);
        for (int idx = lbid() * 512 + tid; idx < NLORA * (KLORA / 8); idx += lgdim() * 512) {
            const int ko = idx / NLORA, r = idx % NLORA, blk = r >> 10, c = r & 1023; float v[8];
#pragma unroll
            for (int j = 0; j < 8; ++j) { const int k = ko * 8 + j; float x = 0.f;
                if (blk == 0) { if (k < 64) x = p.in[I_WLU][((size_t)l * 64 + k) * DM + c]; }
                else if (blk == 1) { if (k >= 64 && k < 128) x = p.in[I_ALU][((size_t)l * 64 + (k - 64)) * DM + c]; }
                else { if (k >= 128) x = p.in[I_GLU][((size_t)l * 128 + (k - 128)) * DM + c]; }
                v[j] = x; }
            *(u32x4*)(wlr + (size_t)r * KLORA + ko * 8) = PACK8(v);
        }
    }
    bf16_t* Xb = (bf16_t*)(ws + OFF_XB);
    { const int nth = lgdim() * 512;
      for (int idx0 = lbid() * 512 + tid; idx0 < MT * (DM / 4); idx0 += 4 * nth) {
        f32x4 v[4];
#pragma unroll
        for (int r = 0; r < 4; ++r) { const int idx = idx0 + r * nth < MT * (DM / 4) ? idx0 + r * nth : idx0; const int m = idx >> 8, c4 = (idx & 255) * 4; const float* sp;
            if (m < MP) { const int b = m / LP, t = m % LP; sp = t < NMETA ? p.in[I_META] + (size_t)t * DM : p.in[I_XP] + ((size_t)b * SEQ + (t - NMETA)) * DM; } else sp = p.in[I_XS] + (size_t)(m - MP) * DM;
            v[r] = __builtin_nontemporal_load((const f32x4*)(sp + c4)); }
#pragma unroll
        for (int r = 0; r < 4; ++r) { const int idx = idx0 + r * nth; if (idx < MT * (DM / 4)) { const int m = idx >> 8, c4 = (idx & 255) * 4;
            *(u32x2*)(Xb + (size_t)m * DM + c4) = (u32x2){pk2(v[r][0], v[r][1]), pk2(v[r][2], v[r][3])}; } }
      } }
}

#define EPI_LOOP_AM for (int ai = 0; ai < 2; ++ai) for (int m = 0; m < 4; ++m)
struct EpiU {
    static constexpr bool PERM = true, AFTER_DRAIN = false; bf16_t* U; float* DTb;
    __device__ __forceinline__ void operator()(const f32x4 (&acc)[2][2][4][2], const Unit& u, int wr, int wc, int fr, int fq) const {
        const int row0 = u.pm * 256 + wr * 64 + fr, col0 = u.pn * 256 + wc * 32 + 8 * fq;
#pragma unroll
        for (int ai = 0; ai < 2; ++ai)
#pragma unroll
            for (int m = 0; m < 4; ++m) { bf16_t* rowp = U + (size_t)(row0 + ai * 128 + m * 16) * NP + col0;
#pragma unroll
                for (int bj = 0; bj < 2; ++bj) { const f32x4 v0 = acc[ai][bj][m][0], v1 = acc[ai][bj][m][1];
                    *(u32x4*)(rowp + bj * 128) = (u32x4){pk2(v0[0], v0[1]), pk2(v0[2], v0[3]), pk2(v1[0], v1[1]), pk2(v1[2], v1[3])}; } }
        if (u.pn == C_DT / 256 && wc == 0) {
#pragma unroll
            for (int ai = 0; ai < 2; ++ai)
#pragma unroll
                for (int m = 0; m < 4; ++m) { float* d = DTb + (size_t)(row0 + ai * 128 + m * 16) * 32 + 8 * fq; *(f32x4*)d = acc[ai][0][m][0]; *(f32x4*)(d + 4) = acc[ai][0][m][1]; }
        }
    }
};
struct EpiLora {
    static constexpr bool PERM = true, AFTER_DRAIN = false; bf16_t* LOR; const float* w0; const float* a0;
    __device__ __forceinline__ void operator()(const f32x4 (&acc)[2][2][4][2], const Unit& u, int wr, int wc, int fr, int fq) const {
        const int row0 = u.pm * 256 + wr * 64 + fr, col0 = u.pn * 256 + wc * 32 + 8 * fq, kind = u.pn >> 2;
        const bool sg = kind < 2; const float* bias = kind == 0 ? w0 + col0 : a0 + (col0 - 1024);
        f32x4 bv[2][2];
#pragma unroll
        for (int bj = 0; bj < 2; ++bj)
#pragma unroll
            for (int n = 0; n < 2; ++n) { bv[bj][n] = (f32x4){0.f, 0.f, 0.f, 0.f}; if (sg) bv[bj][n] = *(const f32x4*)(bias + bj * 128 + n * 4); }
#pragma unroll
        for (int ai = 0; ai < 2; ++ai)
#pragma unroll
            for (int m = 0; m < 4; ++m) { bf16_t* rowp = LOR + (size_t)(row0 + ai * 128 + m * 16) * NLORA + col0;
#pragma unroll
                for (int bj = 0; bj < 2; ++bj) { float o[8];
#pragma unroll
                    for (int n = 0; n < 2; ++n)
#pragma unroll
                        for (int j = 0; j < 4; ++j) { const float x = acc[ai][bj][m][n][j] + bv[bj][n][j]; const float y = sigm(x); o[n * 4 + j] = sg ? y : x; }
                    *(u32x4*)(rowp + bj * 128) = PACK8(o); } }
    }
};
template <int MODE> struct EpiMerge {
    static constexpr bool PERM = true, AFTER_DRAIN = false; bf16_t* T; bf16_t* MG; const bf16_t* U;
    __device__ __forceinline__ void elem(int row, int col, float v) const { const float gq = sigm(bf2f(U[(size_t)row * NP + (MODE == 0 ? C_GS : C_GR) + col])) * v;
        if (MODE == 0) T[(size_t)row * DM + col] = f2bf(gq); else MG[(size_t)row * DM + col] = f2bf(bf2f(T[(size_t)row * DM + col]) + gq); }
    __device__ __forceinline__ void operator()(const f32x4 (&acc)[2][2][4][2], const Unit& u, int wr, int wc, int fr, int fq) const {
        const int row0 = u.pm * 256 + wr * 64 + fr, col0 = u.pn * 256 + wc * 32 + 8 * fq;
#pragma unroll
        for (int ai = 0; ai < 2; ++ai)
#pragma unroll
            for (int m = 0; m < 4; ++m) { const size_t row = (size_t)(row0 + ai * 128 + m * 16);
#pragma unroll
                for (int bj = 0; bj < 2; ++bj) { const int col = col0 + bj * 128;
                    const uint4 gw = *(const uint4*)(U + row * NP + (MODE == 0 ? C_GS : C_GR) + col); float gf[8], o[8]; UNPACK8(gw, gf);
#pragma unroll
                    for (int n = 0; n < 2; ++n)
#pragma unroll
                        for (int j = 0; j < 4; ++j) o[n * 4 + j] = sigm(gf[n * 4 + j]) * acc[ai][bj][m][n][j];
                    if (MODE == 0) *(u32x4*)(T + row * DM + col) = PACK8(o);
                    else { const uint4 tw = *(const uint4*)(T + row * DM + col); float tf[8]; UNPACK8(tw, tf);
#pragma unroll
                        for (int e = 0; e < 8; ++e) o[e] += tf[e];
                        *(u32x4*)(MG + row * DM + col) = PACK8(o); } }
                asm volatile("" ::: "memory"); }
    }
};
struct EpiResid {
    static constexpr bool PERM = true, AFTER_DRAIN = false; bf16_t* T; const bf16_t* R;
    __device__ __forceinline__ void elem(int row, int col, float v) const { T[(size_t)row * DM + col] = f2bf(ALPHA * bf2f(R[(size_t)row * DM + col]) + v); }
    __device__ __forceinline__ void operator()(const f32x4 (&acc)[2][2][4][2], const Unit& u, int wr, int wc, int fr, int fq) const {
        const int row0 = u.pm * 256 + wr * 64 + fr, col0 = u.pn * 256 + wc * 32 + 8 * fq;
#pragma unroll
        for (int ai = 0; ai < 2; ++ai)
#pragma unroll
            for (int m = 0; m < 4; ++m) { const size_t off = (size_t)(row0 + ai * 128 + m * 16) * DM + col0;
#pragma unroll
                for (int bj = 0; bj < 2; ++bj) { const uint4 rw = *(const uint4*)(R + off + bj * 128); float rf[8], o[8]; UNPACK8(rw, rf);
#pragma unroll
                    for (int n = 0; n < 2; ++n)
#pragma unroll
                        for (int j = 0; j < 4; ++j) o[n * 4 + j] = rf[n * 4 + j] * ALPHA + acc[ai][bj][m][n][j];
                    *(u32x4*)(T + off + bj * 128) = PACK8(o); }
                asm volatile("" ::: "memory"); }
    }
};
struct EpiSwiglu {
    static constexpr bool PERM = true, AFTER_DRAIN = false; bf16_t* ACT;
    __device__ __forceinline__ void operator()(const f32x4 (&acc)[2][2][4][2], const Unit& u, int wr, int wc, int fr, int fq) const {
        const int row0 = u.pm * 256 + wr * 64 + fr, col0 = u.pn * 128 + wc * 32 + 8 * fq;
#pragma unroll
        for (int ai = 0; ai < 2; ++ai)
#pragma unroll
            for (int m = 0; m < 4; ++m) { float o[8];
#pragma unroll
                for (int n = 0; n < 2; ++n)
#pragma unroll
                    for (int j = 0; j < 4; ++j) o[n * 4 + j] = siluf(acc[ai][0][m][n][j]) * acc[ai][1][m][n][j];
                *(u32x4*)(ACT + (size_t)(row0 + ai * 128 + m * 16) * DFF + col0) = PACK8(o); }
    }
};

#define MFMA16(a, b, c) __builtin_amdgcn_mfma_f32_16x16x32_bf16((a), (b), (c), 0, 0, 0)

constexpr int MTAIL0 = 16384;
template <class Epi> __device__ __forceinline__ void gemm_tail(const bf16_t* __restrict__ A, int lda, const bf16_t* __restrict__ Bt, int K, const Epi& E, unsigned char* smem) {
    const int tid = ltid(), lane = tid & 63, w = tid >> 6, l15 = lane & 15, q4 = lane >> 4; float* part = (float*)smem;
    for (int u = lbid(); u < 256; u += lgdim()) {
        const int rbk = u >> 4, cb0 = (u & 15) * 4, ks = K >> 8;
        const bf16_t* ap = A + (size_t)(MTAIL0 + rbk * 16 + l15) * lda + (size_t)w * (K >> 3) + q4 * 8;
        const bf16_t* bp = Bt + (size_t)(cb0 * 16 + l15) * K + (size_t)w * (K >> 3) + q4 * 8;
        f32x4 acc[4];
#pragma unroll
        for (int b = 0; b < 4; ++b) acc[b] = (f32x4){0.f, 0.f, 0.f, 0.f};
#pragma unroll 4
        for (int k = 0; k < ks; ++k) { const bf16x8 a = *(const bf16x8*)(ap + k * 32);
#pragma unroll
            for (int b = 0; b < 4; ++b) { const bf16x8 bb = *(const bf16x8*)(bp + (size_t)b * 16 * K + k * 32); acc[b] = MFMA16(a, bb, acc[b]); } }
#pragma unroll
        for (int b = 0; b < 4; ++b)
#pragma unroll
            for (int jj = 0; jj < 4; ++jj) part[((w * 4 + b) * 4 + jj) * 64 + lane] = acc[b][jj];
        __syncthreads();
#pragma unroll
        for (int r = 0; r < 2; ++r) { const int o = tid + r * 512, b = o >> 8, e = o & 255, jj = e >> 6, ln = e & 63; float v = 0.f;
#pragma unroll
            for (int ww = 0; ww < 8; ++ww) v += part[((ww * 4 + b) * 4 + jj) * 64 + ln];
            E.elem(MTAIL0 + rbk * 16 + (ln >> 4) * 4 + jj, (cb0 + b) * 16 + (ln & 15), v); }
        __syncthreads();
    }
}
__device__ __forceinline__ float block_sum(float v, float* red, int tid) {
    v += __shfl_xor(v, 1); v += __shfl_xor(v, 2); v += __shfl_xor(v, 4); v += __shfl_xor(v, 8); v += __shfl_xor(v, 16); v += __shfl_xor(v, 32);
    __syncthreads();
    if ((tid & 63) == 0) red[tid >> 6] = v;
    __syncthreads();
    return ((red[0] + red[1]) + (red[2] + red[3])) + ((red[4] + red[5]) + (red[6] + red[7]));
}
#define WRED(v) do { v += __shfl_xor(v, 1); v += __shfl_xor(v, 2); v += __shfl_xor(v, 4); v += __shfl_xor(v, 8); v += __shfl_xor(v, 16); v += __shfl_xor(v, 32); } while (0)
__device__ __forceinline__ void ln_phase(const Params& p, const bf16_t* T, const float* g, const float* b, bf16_t* Xbo, bool fin) {
    const int tid = ltid(), lane = tid & 63, wv = tid >> 6;
    f32x4 gk[4], bk[4];
#pragma unroll
    for (int k = 0; k < 4; ++k) { gk[k] = *(const f32x4*)(g + k * 256 + lane * 4); bk[k] = *(const f32x4*)(b + k * 256 + lane * 4); }
    const int stride = lgdim() * 8;
    for (int m0 = lbid() * 8 + wv; m0 < MT; m0 += 2 * stride) {
        u32x2 tw[2][4];
#pragma unroll
        for (int r = 0; r < 2; ++r) { const int m = m0 + r * stride < MT ? m0 + r * stride : m0;
#pragma unroll
            for (int k = 0; k < 4; ++k) tw[r][k] = *(const u32x2*)(T + (size_t)m * DM + k * 256 + lane * 4); }
#pragma unroll
        for (int r = 0; r < 2; ++r) { const int m = m0 + r * stride; if (m < MT) {
            f32x4 v[4]; float s = 0.f;
#pragma unroll
            for (int k = 0; k < 4; ++k) { v[k] = (f32x4){__uint_as_float(tw[r][k].x << 16), __uint_as_float(tw[r][k].x & 0xffff0000u), __uint_as_float(tw[r][k].y << 16), __uint_as_float(tw[r][k].y & 0xffff0000u)}; s += (v[k][0] + v[k][1]) + (v[k][2] + v[k][3]); }
            WRED(s); const float mean = s * (1.f / DM); float q = 0.f;
#pragma unroll
            for (int k = 0; k < 4; ++k) { v[k] -= mean; q += (v[k][0] * v[k][0] + v[k][1] * v[k][1]) + (v[k][2] * v[k][2] + v[k][3] * v[k][3]); }
            WRED(q); const float rs = rsqrtf(q * (1.f / DM) + 1e-5f);
            float* dst = nullptr;
            if (fin) { if (m >= MP) dst = p.out + OUT_YSM + (size_t)(m - MP) * DM; else { const int bb = m / LP, t = m % LP; if (t >= NMETA) dst = p.out + OUT_YP + ((size_t)bb * SEQ + (t - NMETA)) * DM; } }
#pragma unroll
            for (int k = 0; k < 4; ++k) { const f32x4 o = v[k] * rs * gk[k] + bk[k];
                if (dst) __builtin_nontemporal_store(o, (f32x4*)(dst + k * 256 + lane * 4));
                if (!fin) *(u32x2*)(Xbo + (size_t)m * DM + k * 256 + lane * 4) = (u32x2){pk2(o[0], o[1]), pk2(o[2], o[3])}; } } }
    }
}
__device__ __forceinline__ void prep_phase(const Params& p, int l) {
    const int tid = ltid(), lane = tid & 63, wv = tid >> 6; const bf16_t* U = (const bf16_t*)(p.ws + OFF_U); bf16_t* AP = (bf16_t*)(p.ws + OFF_AP);
    const f32x4 mu4 = *(const f32x4*)(p.in[I_MU] + (size_t)l * RC + 3072 + lane * 4);
    for (int m = lbid() * 8 + wv; m < MT; m += lgdim() * 8) {
        const bf16_t* ur = U + (size_t)m * NP;
        { const int rc = 3072 + lane * 4; const u32x2 uw = *(const u32x2*)(ur + C_R + rc);
          float u[4] = {__uint_as_float(uw.x << 16), __uint_as_float(uw.x & 0xffff0000u), __uint_as_float(uw.y << 16), __uint_as_float(uw.y & 0xffff0000u)}; float pv[4];
          if (m < MP) { if (m % LP) { const u32x2 pw = *(const u32x2*)(ur - NP + C_R + rc); pv[0] = __uint_as_float(pw.x << 16); pv[1] = __uint_as_float(pw.x & 0xffff0000u); pv[2] = __uint_as_float(pw.y << 16); pv[3] = __uint_as_float(pw.y & 0xffff0000u); }
                        else { pv[0] = pv[1] = pv[2] = pv[3] = 0.f; } }
          else { const f32x4 q = *(const f32x4*)(p.in[I_SSHIFT] + ((size_t)l * NS + (m - MP)) * RC + rc); pv[0] = q[0]; pv[1] = q[1]; pv[2] = q[2]; pv[3] = q[3]; }
          float o[4];
#pragma unroll
          for (int j = 0; j < 4; ++j) { const float sv = u[j] + (pv[j] - u[j]) * mu4[j]; o[j] = lane < 16 ? tanhf(sv) : (lane < 32 ? sv : sigm(sv)); }
          *(u32x2*)(AP + (size_t)m * KLORA + lane * 4) = (u32x2){pk2(o[0], o[1]), pk2(o[2], o[3])}; }
        if (m < MP) { const int b = m / LP, t = m % LP;
            if (t >= LP - 3) { float* d = p.out + OUT_CONVP + (((size_t)l * NB + b) * 3 + (t - (LP - 3))) * CD; _Pragma("unroll 4") for (int c = lane; c < CD; c += 64) d[c] = bf2f(ur[C_X + c]); }
            if (t == LP - 1) { float* d = p.out + OUT_SHP + ((size_t)l * NB + b) * RC; _Pragma("unroll 4") for (int c = lane; c < RC; c += 64) d[c] = bf2f(ur[C_R + c]); }
        } else { const int sx = m - MP; float* d = p.out + OUT_CONVS + ((size_t)l * NS + sx) * 3 * CD; const float* sc = p.in[I_SCONV] + ((size_t)l * NS + sx) * 3 * CD;
            _Pragma("unroll 2") for (int c = lane; c < CD; c += 64) { d[c] = sc[CD + c]; d[CD + c] = sc[2 * CD + c]; d[2 * CD + c] = bf2f(ur[C_X + c]); }
            float* d2 = p.out + OUT_SHS + ((size_t)l * NS + sx) * RC; _Pragma("unroll 4") for (int c = lane; c < RC; c += 64) d2[c] = bf2f(ur[C_R + c]); }
    }
}
__device__ __forceinline__ void post_phase(const Params& p, int l) {
    const int tid = ltid(), lane = tid & 63, wv = tid >> 6; bf16_t* U = (bf16_t*)(p.ws + OFF_U);
    const bf16_t* O = (const bf16_t*)(p.ws + OFF_O); const bf16_t* LOR = (const bf16_t*)(p.ws + OFF_LOR); const float* BON = (const float*)(p.ws + OFF_BON);
    const float* ssqp = (const float*)(p.ws + OFF_SSQ);
    const float* nwp = p.in[I_SNW] + (size_t)l * DI + lane * 8; const float* lgp = p.in[I_LNXG] + l * DM + lane * 16; const float* lbp = p.in[I_LNXB] + l * DM + lane * 16; const float* mvp = p.in[I_MU] + (size_t)l * RC + 2048 + lane * 16;
    f32x4 nwr[4][2], lgr[4], lbr[4], mvr[4];
#pragma unroll
    for (int k = 0; k < 4; ++k) { nwr[k][0] = *(const f32x4*)(nwp + k * 512); nwr[k][1] = *(const f32x4*)(nwp + k * 512 + 4); lgr[k] = *(const f32x4*)(lgp + k * 4); lbr[k] = *(const f32x4*)(lbp + k * 4); mvr[k] = *(const f32x4*)(mvp + k * 4); }
    for (int m = lbid() * 8 + wv; m < MT; m += lgdim() * 8) {
        f32x4 sq4; { float pv = lane < 32 ? ssqp[(size_t)lane * MT + m] : 0.f; pv = red8(pv); sq4[0] = __shfl(pv, 0); sq4[1] = __shfl(pv, 8); sq4[2] = __shfl(pv, 16); sq4[3] = __shfl(pv, 24); }
#pragma unroll
        for (int k = 0; k < 4; ++k) { bf16_t* y = U + (size_t)m * NP + k * 512 + lane * 8; const uint4 w = *(const uint4*)y; float f[8]; UNPACK8(w, f);
            const float rs = rsqrtf(sq4[k] * (1.f / 512.f) + 1e-5f); const f32x4 n0 = nwr[k][0], n1 = nwr[k][1];
#pragma unroll
            for (int e = 0; e < 4; ++e) { f[e] *= rs * n0[e]; f[4 + e] *= rs * n1[e]; }
            *(u32x4*)y = PACK8(f); }
        { f32x4 o[4]; float s = 0.f;
          { const bf16_t* op = O + (size_t)m * DM + lane * 16; const uint4 oa = *(const uint4*)op, ob = *(const uint4*)(op + 8); float of[16]; UNPACK8(oa, of); float* of2 = of + 8; UNPACK8(ob, of2);
#pragma unroll
            for (int k = 0; k < 4; ++k) { o[k] = (f32x4){of[k * 4], of[k * 4 + 1], of[k * 4 + 2], of[k * 4 + 3]}; s += (o[k][0] + o[k][1]) + (o[k][2] + o[k][3]); } }
          s += __shfl_xor(s, 1); s += __shfl_xor(s, 2); const float mu = s * (1.f / 64.f); float q = 0.f;
#pragma unroll
          for (int k = 0; k < 4; ++k) { o[k] -= mu; q += (o[k][0] * o[k][0] + o[k][1] * o[k][1]) + (o[k][2] * o[k][2] + o[k][3] * o[k][3]); }
          q += __shfl_xor(q, 1); q += __shfl_xor(q, 2); const float rs = rsqrtf(q * (1.f / 64.f) + 64e-5f);
          const bf16_t* uv = U + (size_t)m * NP + C_R + 2048 + lane * 16; float u[16], pv[16];
          { const uint4 a = *(const uint4*)uv, b = *(const uint4*)(uv + 8); UNPACK8(a, u); float* u2 = u + 8; UNPACK8(b, u2); }
          if (m < MP) { if (m % LP) { const uint4 a = *(const uint4*)(uv - NP), b = *(const uint4*)(uv - NP + 8); UNPACK8(a, pv); float* p2 = pv + 8; UNPACK8(b, p2); }
                        else {
#pragma unroll
                            for (int e = 0; e < 16; ++e) pv[e] = 0.f; } }
          else { const float* sh = p.in[I_SSHIFT] + ((size_t)l * NS + (m - MP)) * RC + 2048 + lane * 16;
#pragma unroll
              for (int k = 0; k < 4; ++k) { const f32x4 t = *(const f32x4*)(sh + k * 4); pv[k * 4] = t[0]; pv[k * 4 + 1] = t[1]; pv[k * 4 + 2] = t[2]; pv[k * 4 + 3] = t[3]; } }
          const float bo = BON[(size_t)m * 16 + (lane >> 2)]; float r[16];
          float ggv[16]; { const bf16_t* gp = LOR + (size_t)m * NLORA + 2048 + lane * 16; const uint4 a = *(const uint4*)gp, b = *(const uint4*)(gp + 8); UNPACK8(a, ggv); float* g2 = ggv + 8; UNPACK8(b, g2); }
#pragma unroll
          for (int k = 0; k < 4; ++k) { const f32x4 gg = (f32x4){ggv[k * 4], ggv[k * 4 + 1], ggv[k * 4 + 2], ggv[k * 4 + 3]}, lg = lgr[k], lb = lbr[k], mv = mvr[k];
#pragma unroll
              for (int j = 0; j < 4; ++j) { const int e = k * 4 + j; const float v = u[e] + (pv[e] - u[e]) * mv[j]; r[e] = (o[k][j] * rs * lg[j] + lb[j] + bo * v) * gg[j]; } }
          bf16_t* yr = U + (size_t)m * NP + C_R + lane * 16;     float* r2 = r + 8; *(u32x4*)yr = PACK8(r); *(u32x4*)(yr + 8) = PACK8(r2); }
    }
}

__device__ __forceinline__ void ssd_unit(const Params& p, int l, int rowbase, int h, float* __restrict__ hout, unsigned char* smem, bool dry = false) {
    const int tid = ltid(), lane = tid & 63, w = tid >> 6, g = h >> 3, l15 = lane & 15, q4 = lane >> 4;
    bf16_t* Cs = (bf16_t*)smem;
    bf16_t* Bs = Cs + 64 * 136;
    bf16_t* BTw = Bs + 64 * 136;
    bf16_t* XT = BTw + 128 * 72;
    bf16_t* Ms = XT + 64 * 72;
    bf16_t* Hs = Ms + 64 * 72;
    bf16_t* Xs = Hs + 64 * 136;
    bf16_t* Zs = Xs + 64 * 72;
    float* acum = (float*)(Zs + 64 * 72);
    float* dtv = acum + 64;
    bf16_t* Ys = (bf16_t*)(dtv + 64);
    float* e1 = (float*)(Ys + 64 * 72);
    float* e2 = e1 + 64;
    bf16_t* U = (bf16_t*)(p.ws + OFF_U); const float* DTb = (const float*)(p.ws + OFF_DT);
    float* ssqp = (float*)(p.ws + OFF_SSQ) + (size_t)h * MT;
    const float av = -__expf(p.in[I_ALOG][l * NH + h]), dtb = p.in[I_DTB][l * NH + h], Dk = p.in[I_DSKIP][l * NH + h];
    f32x4 hacc[4];
#pragma unroll
    for (int pt = 0; pt < 4; ++pt)
#pragma unroll
        for (int jj = 0; jj < 4; ++jj) { hacc[pt][jj] = 0.f; Hs[(pt * 16 + q4 * 4 + jj) * 136 + w * 16 + l15] = 0; }
    constexpr int T = LP, nch = (T + 63) >> 6, pad = nch * 64 - T;
    const int xi = tid >> 3, xo = tid & 7;
    const int bi = tid >> 4, bo = tid & 15;
    uint4 px, pz, pb0, pb1, pc0, pc1; float pdt;
#define SSD_PREFETCH(c_) do { const int _tb = (c_) * 64 - pad; const uint4 _z4 = make_uint4(0u, 0u, 0u, 0u); \
        { const int _t = _tb + xi; px = _z4; pz = _z4; if (_t >= 0) { px = *(const uint4*)(U + (size_t)(rowbase + _t) * NP + C_X + h * 64 + xo * 8); pz = *(const uint4*)(U + (size_t)(rowbase + _t) * NP + h * 64 + xo * 8); } } \
        { const int _t = _tb + bi; pb0 = _z4; pc0 = _z4; if (_t >= 0) { const bf16_t* _s = U + (size_t)(rowbase + _t) * NP + C_X + 2048 + g * 128 + bo * 8; pb0 = *(const uint4*)_s; pc0 = *(const uint4*)(_s + 512); } } \
        { const int _t = _tb + bi + 32; pb1 = _z4; pc1 = _z4; if (_t >= 0) { const bf16_t* _s = U + (size_t)(rowbase + _t) * NP + C_X + 2048 + g * 128 + bo * 8; pb1 = *(const uint4*)_s; pc1 = *(const uint4*)(_s + 512); } } \
        pdt = 0.f; if (tid < 64) { const int _t = _tb + tid; if (_t >= 0) pdt = DTb[(size_t)(rowbase + _t) * 32 + h]; } } while (0)
    SSD_PREFETCH(0);
    for (int c = 0; c < nch; ++c) {
        const int tbase = c * 64 - pad;
        *(uint4*)(Xs + xi * 72 + xo * 8) = px; *(uint4*)(Zs + xi * 72 + xo * 8) = pz;
        *(uint4*)(Bs + bi * 136 + bo * 8) = pb0; *(uint4*)(Cs + bi * 136 + bo * 8) = pc0;
        *(uint4*)(Bs + (bi + 32) * 136 + bo * 8) = pb1; *(uint4*)(Cs + (bi + 32) * 136 + bo * 8) = pc1;
        if (tid < 64) { const int t = tbase + tid; const float dt = t >= 0 ? softplusf(pdt + dtb) : 0.f; float x = dt * av;
#pragma unroll
            for (int off = 1; off < 64; off <<= 1) { const float y = __shfl_up(x, off); if (lane >= off) x += y; }
            acum[tid] = x; dtv[tid] = dt; const float xl = __shfl(x, 63); e1[tid] = __expf(xl - x); e2[tid] = __expf(x); }
        if (c + 1 < nch) SSD_PREFETCH(c + 1);
        __syncthreads();
        {
          { const int pp = tid & 63, jq = tid >> 6; float o[8];
#pragma unroll
            for (int e = 0; e < 8; ++e) o[e] = bf2f(Xs[(jq * 8 + e) * 72 + pp]) * dtv[jq * 8 + e];
            *(u32x4*)(XT + pp * 72 + jq * 8) = PACK8(o); }
          { const int n = tid & 127, jq = tid >> 7;
#pragma unroll
            for (int hf = 0; hf < 2; ++hf) { float o[8];
#pragma unroll
                for (int e = 0; e < 8; ++e) { const int j = jq * 16 + hf * 8 + e; o[e] = bf2f(Bs[j * 136 + n]) * e1[j]; }
                *(u32x4*)(BTw + n * 72 + jq * 16 + hf * 8) = PACK8(o); } }
        }
        __syncthreads();
#pragma unroll
        for (int q = 0; q < 2; ++q) { const int tile = 2 * w + q, ti = tile >> 2, tj = tile & 3; f32x4 a4 = (f32x4){0.f, 0.f, 0.f, 0.f};
            if (tj <= ti) {
#pragma unroll
                for (int kk = 0; kk < 4; ++kk) { const bf16x8 a = *(const bf16x8*)(Cs + (ti * 16 + l15) * 136 + kk * 32 + q4 * 8), b = *(const bf16x8*)(Bs + (tj * 16 + l15) * 136 + kk * 32 + q4 * 8); a4 = MFMA16(a, b, a4); } }
#pragma unroll
            for (int jj = 0; jj < 4; ++jj) { const int i = ti * 16 + q4 * 4 + jj, j = tj * 16 + l15; const float v = (j <= i) ? a4[jj] * __expf(acum[i] - acum[j]) : 0.f; Ms[i * 72 + j] = f2bf(v); } }
        { const float cd = e2[63];
#pragma unroll
          for (int pt = 0; pt < 4; ++pt) { hacc[pt] *= cd;
#pragma unroll
              for (int kk = 0; kk < 2; ++kk) { const bf16x8 a = *(const bf16x8*)(XT + (pt * 16 + l15) * 72 + kk * 32 + q4 * 8), b = *(const bf16x8*)(BTw + (w * 16 + l15) * 72 + kk * 32 + q4 * 8); hacc[pt] = MFMA16(a, b, hacc[pt]); } } }
        __syncthreads();
#pragma unroll
        for (int q = 0; q < 2; ++q) { const int tile = 2 * w + q, ti = tile >> 2, tp = tile & 3; f32x4 y4 = (f32x4){0.f, 0.f, 0.f, 0.f};
#pragma unroll
            for (int kk = 0; kk < 4; ++kk) { const bf16x8 a = *(const bf16x8*)(Cs + (ti * 16 + l15) * 136 + kk * 32 + q4 * 8), b = *(const bf16x8*)(Hs + (tp * 16 + l15) * 136 + kk * 32 + q4 * 8); y4 = MFMA16(a, b, y4); }
#pragma unroll
            for (int jj = 0; jj < 4; ++jj) y4[jj] *= e2[ti * 16 + q4 * 4 + jj];
#pragma unroll
            for (int kk = 0; kk < 2; ++kk) { const bf16x8 a = *(const bf16x8*)(Ms + (ti * 16 + l15) * 72 + kk * 32 + q4 * 8), b = *(const bf16x8*)(XT + (tp * 16 + l15) * 72 + kk * 32 + q4 * 8); y4 = MFMA16(a, b, y4); }
#pragma unroll
            for (int jj = 0; jj < 4; ++jj) { const int i = ti * 16 + q4 * 4 + jj, pp = tp * 16 + l15, t = tbase + i;
                const float y = (y4[jj] + bf2f(Xs[i * 72 + pp]) * Dk) * siluf(bf2f(Zs[i * 72 + pp]));
                Ys[i * 72 + pp] = f2bf(y); } }
        __syncthreads();
        { const int row = tid >> 3, oct = tid & 7, t = tbase + row; const uint4 v = *(const uint4*)(Ys + row * 72 + oct * 8); float f[8]; UNPACK8(v, f);
          float sq = (f[0] * f[0] + f[1] * f[1]) + (f[2] * f[2] + f[3] * f[3]) + ((f[4] * f[4] + f[5] * f[5]) + (f[6] * f[6] + f[7] * f[7]));
          sq = red8(sq);
          if (t >= 0) { *(uint4*)(U + (size_t)(rowbase + t) * NP + h * 64 + oct * 8) = v; if (oct == 0) ssqp[rowbase + t] = sq; } }
#pragma unroll
        for (int pt = 0; pt < 4; ++pt)
#pragma unroll
            for (int jj = 0; jj < 4; ++jj) Hs[(pt * 16 + q4 * 4 + jj) * 136 + w * 16 + l15] = f2bf(hacc[pt][jj]);
    }
#pragma unroll
    for (int pt = 0; pt < 4; ++pt)
#pragma unroll
        for (int jj = 0; jj < 4; ++jj) hout[(pt * 16 + q4 * 4 + jj) * 128 + w * 16 + l15] = hacc[pt][jj];
    __syncthreads();
#undef SSD_PREFETCH
}

constexpr int RW_BUF = 5 * 2048 + 1024 + 64 + 1024;
__device__ __forceinline__ void rwkv_stage(const Params& p, int l, int rowbase, int T, int h, int half, const float* __restrict__ shprev, int c, float* buf, int tid) {
    const int tl = tid - 256, tt = tl >> 3, part = tl & 7, t = c * 32 + tt, tcl = t < T ? t : T - 1, m = rowbase + tcl, col = h * 64 + part * 8;
    const bf16_t* U = (const bf16_t*)(p.ws + OFF_U); const bf16_t* LOR = (const bf16_t*)(p.ws + OFF_LOR);
    const bf16_t* ur = U + (size_t)m * NP + C_R + col;
    float decs[8], aas[8]; { const uint4 a = *(const uint4*)(LOR + (size_t)m * NLORA + col), b = *(const uint4*)(LOR + (size_t)m * NLORA + 1024 + col); UNPACK8(a, decs); UNPACK8(b, aas); }
    float r[8], k[8], v[8], pr[8], pk[8], pv[8];
    { const uint4 a = *(const uint4*)ur, b = *(const uint4*)(ur + 1024), cx = *(const uint4*)(ur + 2048); UNPACK8(a, r); UNPACK8(b, k); UNPACK8(cx, v); }
    if (tcl > 0) { const uint4 a = *(const uint4*)(ur - NP), b = *(const uint4*)(ur - NP + 1024), cx = *(const uint4*)(ur - NP + 2048); UNPACK8(a, pr); UNPACK8(b, pk); UNPACK8(cx, pv); }
    else {
#pragma unroll
        for (int e = 0; e < 8; ++e) { pr[e] = shprev ? shprev[col + e] : 0.f; pk[e] = shprev ? shprev[1024 + col + e] : 0.f; pv[e] = shprev ? shprev[2048 + col + e] : 0.f; } }
    const float* mu = p.in[I_MU] + (size_t)l * RC + col;
    float ss = 0.f, c1 = 0.f, c2 = 0.f, bon = 0.f; float nkk[8], wr[8], ww[8], bb[8], km[8];
#pragma unroll
    for (int e = 0; e < 8; ++e) {
        r[e] += (pr[e] - r[e]) * mu[e]; k[e] += (pk[e] - k[e]) * mu[1024 + e]; v[e] += (pv[e] - v[e]) * mu[2048 + e];
        const float dec = __expf(-0.6065306597126334f * decs[e]), aa = aas[e];
        const float kkv = k[e] * p.in[I_KK][l * DM + col + e]; ss += kkv * kkv; nkk[e] = kkv;
        km[e] = k[e] * (1.f + (aa - 1.f) * p.in[I_KA][l * DM + col + e]); bb[e] = aa; ww[e] = dec; wr[e] = dec * r[e];
        c2 += km[e] * r[e]; bon += r[e] * km[e] * p.in[I_RK][l * DM + col + e];
    }
    ss = red8(ss); const float inv = rsqrtf(fmaxf(ss, 1e-24f));
#pragma unroll
    for (int e = 0; e < 8; ++e) { const float kk = nkk[e] * inv; bb[e] *= kk; nkk[e] = -kk; c1 += bb[e] * r[e]; }
    c1 = red8(c1); c2 = red8(c2); bon = red8(bon);
#pragma unroll
    for (int e = 0; e < 8; ++e) wr[e] += c1 * nkk[e];
    float* NKK = buf, *WR = buf + 2048, *WW = buf + 4096, *BB = buf + 6144, *KM = buf + 8192, *VV = buf + 10240, *C1 = buf + 11264, *C2 = buf + 11296;
    const int o = tt * 64 + part * 8;
    *(f32x4*)(NKK + o) = (f32x4){nkk[0], nkk[1], nkk[2], nkk[3]}; *(f32x4*)(NKK + o + 4) = (f32x4){nkk[4], nkk[5], nkk[6], nkk[7]};
    *(f32x4*)(WR + o) = (f32x4){wr[0], wr[1], wr[2], wr[3]}; *(f32x4*)(WR + o + 4) = (f32x4){wr[4], wr[5], wr[6], wr[7]};
    *(f32x4*)(WW + o) = (f32x4){ww[0], ww[1], ww[2], ww[3]}; *(f32x4*)(WW + o + 4) = (f32x4){ww[4], ww[5], ww[6], ww[7]};
    *(f32x4*)(BB + o) = (f32x4){bb[0], bb[1], bb[2], bb[3]}; *(f32x4*)(BB + o + 4) = (f32x4){bb[4], bb[5], bb[6], bb[7]};
    *(f32x4*)(KM + o) = (f32x4){km[0], km[1], km[2], km[3]}; *(f32x4*)(KM + o + 4) = (f32x4){km[4], km[5], km[6], km[7]};
    if ((part >> 2) == half) { float* d = VV + tt * 32 + (part & 3) * 8; *(f32x4*)d = (f32x4){v[0], v[1], v[2], v[3]}; *(f32x4*)(d + 4) = (f32x4){v[4], v[5], v[6], v[7]}; }
    if (part == 0) { C1[tt] = c1; C2[tt] = c2; if (half == 0 && t < T) ((float*)(p.ws + OFF_BON))[(size_t)m * 16 + h] = bon; }
}
__device__ __forceinline__ void rwkv_unit(const Params& p, int l, int rowbase, int T, int h, int half, const float* __restrict__ S0, const float* __restrict__ shprev, float* __restrict__ Sout, unsigned char* smem) {
    const int tid = ltid(); float* base = (float*)smem; bf16_t* O = (bf16_t*)(p.ws + OFF_O);
    const int il = tid >> 3, jo = tid & 7;
    f32x2 S2[4];
    if (tid < 256) {
#pragma unroll
        for (int e = 0; e < 4; ++e) { S2[e].x = S0 ? S0[(half * 32 + il) * 64 + jo * 8 + 2 * e] : 0.f; S2[e].y = S0 ? S0[(half * 32 + il) * 64 + jo * 8 + 2 * e + 1] : 0.f; } }
    const int nch = (T + 31) >> 5;
    if (tid >= 256) rwkv_stage(p, l, rowbase, T, h, half, shprev, 0, base, tid);
    __syncthreads();
    for (int c = 0; c < nch; ++c) {
        float* buf = base + (c & 1) * RW_BUF;
        if (tid >= 256) { if (c + 1 < nch) rwkv_stage(p, l, rowbase, T, h, half, shprev, c + 1, base + ((c + 1) & 1) * RW_BUF, tid); }
        else {
            if (c > 0 && tid < 128) { const float* OBp = base + ((c - 1) & 1) * RW_BUF + 11328; const int s = tid >> 2, qq = tid & 3, t = (c - 1) * 32 + s;
                if (t < T) { const f32x4 ov = *(const f32x4*)(OBp + s * 32 + qq * 8), ow = *(const f32x4*)(OBp + s * 32 + qq * 8 + 4); *(u32x4*)(O + (size_t)(rowbase + t) * DM + h * 64 + half * 32 + qq * 8) = (u32x4){pk2(ov[0], ov[1]), pk2(ov[2], ov[3]), pk2(ow[0], ow[1]), pk2(ow[2], ow[3])}; } }
            const float* NKK = buf, *WR = buf + 2048, *WW = buf + 4096, *BB = buf + 6144, *KM = buf + 8192, *VV = buf + 10240, *C1 = buf + 11264, *C2 = buf + 11296; float* OB = buf + 11328;
            const int steps = (T - c * 32) < 32 ? (T - c * 32) : 32;
            __builtin_amdgcn_s_setprio(3);
            for (int s = 0; s < steps; ++s) {
                const int o = s * 64 + jo * 8;
                const f32x4 n0 = *(const f32x4*)(NKK + o), n1 = *(const f32x4*)(NKK + o + 4), r0 = *(const f32x4*)(WR + o), r1 = *(const f32x4*)(WR + o + 4);
                const f32x4 w0 = *(const f32x4*)(WW + o), w1 = *(const f32x4*)(WW + o + 4), b0 = *(const f32x4*)(BB + o), b1 = *(const f32x4*)(BB + o + 4), k0 = *(const f32x4*)(KM + o), k1 = *(const f32x4*)(KM + o + 4);
                const float vi = VV[s * 32 + il], c2 = C2[s];
                f32x2 pa = S2[0] * n0.lo, pb = S2[0] * r0.lo;
                pa = __builtin_elementwise_fma(S2[1], n0.hi, pa); pb = __builtin_elementwise_fma(S2[1], r0.hi, pb);
                pa = __builtin_elementwise_fma(S2[2], n1.lo, pa); pb = __builtin_elementwise_fma(S2[2], r1.lo, pb);
                pa = __builtin_elementwise_fma(S2[3], n1.hi, pa); pb = __builtin_elementwise_fma(S2[3], r1.hi, pb);
                const float sa = red8(pa.x + pa.y), po = red8(pb.x + pb.y);
                const f32x2 sa2 = (f32x2){sa, sa}, vi2 = (f32x2){vi, vi};
                S2[0] = __builtin_elementwise_fma(S2[0], w0.lo, __builtin_elementwise_fma(b0.lo, sa2, k0.lo * vi2));
                S2[1] = __builtin_elementwise_fma(S2[1], w0.hi, __builtin_elementwise_fma(b0.hi, sa2, k0.hi * vi2));
                S2[2] = __builtin_elementwise_fma(S2[2], w1.lo, __builtin_elementwise_fma(b1.lo, sa2, k1.lo * vi2));
                S2[3] = __builtin_elementwise_fma(S2[3], w1.hi, __builtin_elementwise_fma(b1.hi, sa2, k1.hi * vi2));
                OB[s * 32 + il] = fmaf(vi, c2, po);
            }
            __builtin_amdgcn_s_setprio(0);
        }
        __syncthreads();
    }
    if (tid < 256) {
        if (tid < 128) { const float* OBp = base + ((nch - 1) & 1) * RW_BUF + 11328; const int s = tid >> 2, qq = tid & 3, t = (nch - 1) * 32 + s;
          if (t < T) { const f32x4 ov = *(const f32x4*)(OBp + s * 32 + qq * 8), ow = *(const f32x4*)(OBp + s * 32 + qq * 8 + 4); *(u32x4*)(O + (size_t)(rowbase + t) * DM + h * 64 + half * 32 + qq * 8) = (u32x4){pk2(ov[0], ov[1]), pk2(ov[2], ov[3]), pk2(ow[0], ow[1]), pk2(ow[2], ow[3])}; } }
#pragma unroll
        for (int e = 0; e < 4; ++e) { Sout[(half * 32 + il) * 64 + jo * 8 + 2 * e] = S2[e].x; Sout[(half * 32 + il) * 64 + jo * 8 + 2 * e + 1] = S2[e].y; }
    }
    __syncthreads();
}

__device__ __forceinline__ void ssd_sample_unit(const Params& p, int l, int s, int hh, unsigned char* smem) {
    const int tid = ltid(), m = MP + s;
    float* xs = (float*)smem;
    float* bc = xs + 1024;
    float* ysq = bc + 512;
    float* yb = ysq + 1024;
    bf16_t* U = (bf16_t*)(p.ws + OFF_U); const float* DTb = (const float*)(p.ws + OFF_DT);
    float* ssqp = (float*)(p.ws + OFF_SSQ);
    const float* pre = p.in[I_SCONV] + ((size_t)l * NS + s) * 3 * CD; bf16_t* ur = U + (size_t)m * NP;
    for (int q = tid; q < 1536; q += 512) {
        int cc; if (q < 1024) cc = hh * 1024 + q; else { const int r = q - 1024, gg = r >> 8, bcs = (r >> 7) & 1, n = r & 127; cc = 2048 + bcs * 512 + (hh * 2 + gg) * 128 + n; }
        const float* cw = p.in[I_CONVW] + (size_t)l * 4 * CD + cc;
        const float v = p.in[I_CONVB][(size_t)l * CD + cc] + cw[0] * pre[cc] + cw[CD] * pre[CD + cc] + cw[2 * CD] * pre[2 * CD + cc] + cw[3 * CD] * bf2f(ur[C_X + cc]);
        const float a = siluf(v); if (q < 1024) xs[q] = a; else bc[q - 1024] = a;
    }
    __syncthreads();
    const int lane32 = tid & 31, prow = tid >> 5;
    f32x4 hnx[4];
    { const float* h00 = p.in[I_SSSM] + (((size_t)l * NS + s) * NH + hh * 16) * 8192;
#pragma unroll
      for (int k = 0; k < 4; ++k) hnx[k] = __builtin_nontemporal_load((const f32x4*)(h00 + (size_t)(k * 512 + tid) * 4)); }
    for (int hi = 0; hi < 16; ++hi) {
        const int h = hh * 16 + hi, gg = hi >> 3;
        const float* h0 = p.in[I_SSSM] + (((size_t)l * NS + s) * NH + h) * 8192; float* ho = p.out + OUT_SSMS + (((size_t)l * NS + s) * NH + h) * 8192;
        f32x4 hv[4];
#pragma unroll
        for (int k = 0; k < 4; ++k) hv[k] = hnx[k];
        if (hi + 1 < 16) {
#pragma unroll
            for (int k = 0; k < 4; ++k) hnx[k] = __builtin_nontemporal_load((const f32x4*)(h0 + 8192 + (size_t)(k * 512 + tid) * 4)); }
        const float dt = softplusf(DTb[(size_t)m * 32 + h] + p.in[I_DTB][l * NH + h]), dA = __expf(-dt * __expf(p.in[I_ALOG][l * NH + h])), Dk = p.in[I_DSKIP][l * NH + h];
        const f32x4 Bv = *(const f32x4*)(bc + gg * 256 + lane32 * 4), Cv = *(const f32x4*)(bc + gg * 256 + 128 + lane32 * 4);
#pragma unroll
        for (int k = 0; k < 4; ++k) { const int pp = k * 16 + prow; const float xv = xs[hi * 64 + pp], xd = xv * dt;
            f32x4 hn = hv[k] * dA + Bv * xd; __builtin_nontemporal_store(hn, (f32x4*)(ho + (size_t)(k * 512 + tid) * 4));
            float y = (hn[0] * Cv[0] + hn[1] * Cv[1]) + (hn[2] * Cv[2] + hn[3] * Cv[3]);
            y += __shfl_xor(y, 1); y += __shfl_xor(y, 2); y += __shfl_xor(y, 4); y += __shfl_xor(y, 8); y += __shfl_xor(y, 16);
            if (lane32 == 0) { const float yo = (y + xv * Dk) * siluf(bf2f(ur[h * 64 + pp])); yb[hi * 64 + pp] = yo; ysq[(hi * 16 + prow) * 4 + k] = yo * yo; } }
    }
    __syncthreads();
    if (tid < 2) { float a = 0.f; for (int i = 0; i < 512; ++i) a += ysq[tid * 512 + i]; const int g0 = (hh * 2 + tid) * 8; ssqp[(size_t)g0 * MT + m] = a;
#pragma unroll
        for (int e = 1; e < 8; ++e) ssqp[(size_t)(g0 + e) * MT + m] = 0.f; }
    if (tid >= 64 && tid < 192) { const int o8 = (tid - 64) * 8; float f[8];
#pragma unroll
        for (int e = 0; e < 8; ++e) f[e] = yb[o8 + e];
        *(u32x4*)(ur + hh * 1024 + o8) = PACK8(f); }
    __syncthreads();
}
__device__ __forceinline__ void rwkv_sample_unit(const Params& p, int l, int s, int hh, unsigned char* smem) {
    const int tid = ltid(), m = MP + s, col = hh * 512 + tid;
    float* NKK = (float*)smem, *WR = NKK + 512, *WW = WR + 512, *BB = WW + 512, *KM = BB + 512, *VV = KM + 512, *C1 = VV + 512, *C2 = C1 + 8; float* OBs = C2 + 8;
    const bf16_t* U = (const bf16_t*)(p.ws + OFF_U); const bf16_t* LOR = (const bf16_t*)(p.ws + OFF_LOR); bf16_t* O = (bf16_t*)(p.ws + OFF_O);
    { const bf16_t* ur = U + (size_t)m * NP + C_R; const float* sh = p.in[I_SSHIFT] + ((size_t)l * NS + s) * RC; const float* mu = p.in[I_MU] + (size_t)l * RC;
      float r = bf2f(ur[col]), k = bf2f(ur[1024 + col]), v = bf2f(ur[2048 + col]);
      r += (sh[col] - r) * mu[col]; k += (sh[1024 + col] - k) * mu[1024 + col]; v += (sh[2048 + col] - v) * mu[2048 + col];
      const float dec = __expf(-0.6065306597126334f * bf2f(LOR[(size_t)m * NLORA + col])), aa = bf2f(LOR[(size_t)m * NLORA + 1024 + col]);
      float kk = k * p.in[I_KK][l * DM + col]; float ss = kk * kk;
#pragma unroll
      for (int o = 1; o < 64; o <<= 1) ss += __shfl_xor(ss, o);
      kk *= rsqrtf(fmaxf(ss, 1e-24f));
      const float km = k * (1.f + (aa - 1.f) * p.in[I_KA][l * DM + col]), bb = kk * aa;
      float c1 = bb * r, c2 = km * r, bon = r * km * p.in[I_RK][l * DM + col];
#pragma unroll
      for (int o = 1; o < 64; o <<= 1) { c1 += __shfl_xor(c1, o); c2 += __shfl_xor(c2, o); bon += __shfl_xor(bon, o); }
      NKK[tid] = -kk; WR[tid] = dec * r; WW[tid] = dec; BB[tid] = bb; KM[tid] = km; VV[tid] = v;
      if ((tid & 63) == 0) { C1[tid >> 6] = c1; C2[tid >> 6] = c2; ((float*)(p.ws + OFF_BON))[(size_t)m * 16 + hh * 8 + (tid >> 6)] = bon; } }
    __syncthreads();
    const int i = tid >> 3, jo = tid & 7;
    for (int hi = 0; hi < 8; ++hi) {
        const int h = hh * 8 + hi; const size_t so = (((size_t)l * NS + s) * 16 + h) * 4096 + i * 64 + jo * 8;
        const f32x4 s0 = __builtin_nontemporal_load((const f32x4*)(p.in[I_SWKV] + so)), s1 = __builtin_nontemporal_load((const f32x4*)(p.in[I_SWKV] + so + 4));
        const int o = hi * 64 + jo * 8;
        const f32x4 n0 = *(const f32x4*)(NKK + o), n1 = *(const f32x4*)(NKK + o + 4), r0 = *(const f32x4*)(WR + o), r1 = *(const f32x4*)(WR + o + 4);
        const f32x4 w0 = *(const f32x4*)(WW + o), w1 = *(const f32x4*)(WW + o + 4), b0 = *(const f32x4*)(BB + o), b1 = *(const f32x4*)(BB + o + 4), k0 = *(const f32x4*)(KM + o), k1 = *(const f32x4*)(KM + o + 4);
        const float vi = VV[hi * 64 + i];
        float psa = 0.f, po = 0.f;
#pragma unroll
        for (int e = 0; e < 4; ++e) { psa += s0[e] * n0[e] + s1[e] * n1[e]; po += s0[e] * r0[e] + s1[e] * r1[e]; }
        const float sa = red8(psa); po = red8(po);
        const f32x4 t0 = s0 * w0 + (b0 * sa + k0 * vi), t1 = s1 * w1 + (b1 * sa + k1 * vi);
        __builtin_nontemporal_store(t0, (f32x4*)(p.out + OUT_WKVS + so)); __builtin_nontemporal_store(t1, (f32x4*)(p.out + OUT_WKVS + so + 4));
        if (jo == 0) OBs[hi * 64 + i] = po + sa * C1[hi] + vi * C2[hi];
    }
    __syncthreads();
    if (tid < 64) { float f[8];
#pragma unroll
        for (int e = 0; e < 8; ++e) f[e] = OBs[tid * 8 + e];
        *(u32x4*)(O + (size_t)m * DM + hh * 512 + tid * 8) = PACK8(f); }
    __syncthreads();
}
__device__ __forceinline__ void scan_phase(const Params& p, int l, unsigned char* smem) {
    const int G = lgdim(), bx = lbid();
#ifndef PROBE_REP_PROMPT
#define PROBE_REP_PROMPT 1
#endif
    for (int rep = 0; rep < PROBE_REP_PROMPT; ++rep) {
    for (int u = bx; u < NB * NH; u += G) { const int b = u >> 5, h = u & 31;
        ssd_unit(p, l, b * LP, h, p.out + OUT_SSMP + (((size_t)l * NB + b) * NH + h) * 8192, smem, rep > 0); }
    for (int u = bx; u < NB * NH; u += G) { const int b = u >> 5, h = (u & 31) >> 1, half = u & 1;
        rwkv_unit(p, l, b * LP, LP, h, half, nullptr, nullptr, p.out + OUT_WKVP + (((size_t)l * NB + b) * 16 + h) * 4096, smem); }
    }
    for (int u = bx; u < NS * 2; u += G) ssd_sample_unit(p, l, u >> 1, u & 1, smem);
    for (int u = bx; u < NS * 2; u += G) rwkv_sample_unit(p, l, u >> 1, u & 1, smem);
}

#define xb_tid ((int)threadIdx.x)
#define XB_TMO      128
#define XB_XCNT(j)  (256  + 64 * (j))
#define XB_XSUB(j)  (1280 + 64 * (j))
#define XB_XGEN(j)  (2304 + 64 * (j))
#define XB_TOP      3328
#define XB_TOPGEN   3392
#define XCD_BAR_WORDS 3456
#define XB_SPIN_CAP (1u << 18)

__device__ __forceinline__ unsigned xb_ld(unsigned* p)              { return __hip_atomic_load(p, __ATOMIC_RELAXED, __HIP_MEMORY_SCOPE_AGENT); }
__device__ __forceinline__ unsigned xb_add(unsigned* p, unsigned v) { return __hip_atomic_fetch_add(p, v, __ATOMIC_RELAXED, __HIP_MEMORY_SCOPE_AGENT); }
__device__ __forceinline__ unsigned xb_xcc_id() { return (unsigned)__builtin_amdgcn_s_getreg((3 << 11) | 20) & 0xFu; }
#define XB_SPIN(cond, bar) do { unsigned _sp = 0; while (cond) { __builtin_amdgcn_s_sleep(1); \
    if ((++_sp & 255u) == 0u) { if (xb_ld(&(bar)[XB_TMO])) break; if (_sp > XB_SPIN_CAP) { atomicAdd(&(bar)[XB_TMO], 1u); break; } } } } while (0)

struct XcdBarrier {
    unsigned* bar; unsigned x;
    volatile LAS unsigned* st;
};

__device__ __forceinline__ XcdBarrier xcd_barrier_post(unsigned* bar, volatile LAS unsigned* st) {
    XcdBarrier b; b.bar = bar; b.x = xb_xcc_id(); b.st = st;
    if (xb_tid == 0) (void)xb_add(&bar[XB_XCNT(b.x)], 1u);
    return b;
}
__device__ __forceinline__ void xcd_barrier_complete(unsigned* bar, unsigned x, unsigned& nloc, unsigned& nx) {
    const unsigned G = gridDim.x * gridDim.y * gridDim.z;
    unsigned sum, cnt, mine, sp = 0u;
    for (;;) {
        sum = 0u; cnt = 0u; mine = 0u;
#pragma unroll
        for (unsigned j = 0; j < 16; ++j) { const unsigned c = xb_ld(&bar[XB_XCNT(j)]); sum += c; cnt += (c > 0u) ? 1u : 0u; mine = (j == x) ? c : mine; }
        if (sum == G) break;
        __builtin_amdgcn_s_sleep(1);
        if ((++sp & 255u) == 0u) { if (xb_ld(&bar[XB_TMO])) break; if (sp > XB_SPIN_CAP) { atomicAdd(&bar[XB_TMO], 1u); break; } }
    }
    nloc = mine > 0u ? mine : 1u; nx = cnt > 0u ? cnt : 1u;
}

__device__ __forceinline__ void xcd_barrier(const XcdBarrier& b) {
    asm volatile("s_waitcnt vmcnt(0)" ::: "memory");
    __syncthreads();
    if (xb_tid == 0) {
        unsigned* bar = b.bar;
        __builtin_amdgcn_s_waitcnt(0);
        unsigned nloc = b.st[0], nx = b.st[1];
        if (nloc == 0u) { xcd_barrier_complete(bar, b.x, nloc, nx); b.st[0] = nloc; b.st[1] = nx; }
        const unsigned old = xb_add(&bar[XB_XSUB(b.x)], 1u);
        const unsigned gen = old / nloc;
        if (old + 1u == (gen + 1u) * nloc) {
            __builtin_amdgcn_fence(__ATOMIC_RELEASE, "agent");
            asm volatile("s_waitcnt vmcnt(0)" ::: "memory");
            const unsigned og = xb_add(&bar[XB_TOP], 1u);
            const unsigned tg = og / nx;
            if (og + 1u == (tg + 1u) * nx) xb_add(&bar[XB_TOPGEN], 1u);
            else XB_SPIN(xb_ld(&bar[XB_TOPGEN]) == tg, bar);
            __builtin_amdgcn_fence(__ATOMIC_ACQUIRE, "agent");
            xb_add(&bar[XB_XGEN(b.x)], 1u);
            asm volatile("s_waitcnt vmcnt(0)" ::: "memory");
        } else {
            XB_SPIN(xb_ld(&bar[XB_XGEN(b.x)]) == gen, bar);
            __builtin_amdgcn_fence(__ATOMIC_ACQUIRE, "agent");
            asm volatile("s_waitcnt vmcnt(0)" ::: "memory");
        }
    }
    __syncthreads();
}


__device__ __forceinline__ void conv_phase(const Params& p, int l, const XcdBarrier& xbar) {
    const int tid = ltid(); const bool act = tid < 384; bf16_t* U = (bf16_t*)(p.ws + OFF_U);
    const int cc = (act ? tid : 0) * 8, G = lgdim(), w = lbid(), NBLK = MP / 8, rb0 = (int)((long)w * NBLK / G), rb1 = (int)((long)(w + 1) * NBLK / G);
    float cw[4][8], cb[8], w0[8], w1[8], w2[8];
#pragma unroll
    for (int k = 0; k < 4; ++k) { const float* sp = p.in[I_CONVW] + ((size_t)l * 4 + k) * CD + cc; const f32x4 a = *(const f32x4*)sp, b = *(const f32x4*)(sp + 4);
#pragma unroll
        for (int e = 0; e < 4; ++e) { cw[k][e] = a[e]; cw[k][4 + e] = b[e]; } }
    { const float* sp = p.in[I_CONVB] + (size_t)l * CD + cc; const f32x4 a = *(const f32x4*)sp, b = *(const f32x4*)(sp + 4);
#pragma unroll
      for (int e = 0; e < 4; ++e) { cb[e] = a[e]; cb[4 + e] = b[e]; } }
#define CV_LOAD(tt, mm, dst) do { if ((tt) >= 0) { const uint4 _v = *(const uint4*)(U + (size_t)(mm) * NP + C_X + cc); UNPACK8(_v, dst); } else { dst[0] = dst[1] = dst[2] = dst[3] = dst[4] = dst[5] = dst[6] = dst[7] = 0.f; } } while (0)
    { const int m0 = rb0 * 8, t0 = m0 % LP; CV_LOAD(t0 - 3, m0 - 3, w0); CV_LOAD(t0 - 2, m0 - 2, w1); CV_LOAD(t0 - 1, m0 - 1, w2); }
    asm volatile("s_waitcnt vmcnt(0)" ::: "memory");
    xcd_barrier(xbar);
    if (act) {
        for (int rb = rb0; rb < rb1; ++rb) {
            const int m0 = rb * 8;
            if (m0 % LP == 0) {
#pragma unroll
                for (int e = 0; e < 8; ++e) { w0[e] = 0.f; w1[e] = 0.f; w2[e] = 0.f; } }
            uint4 raw[8];
#pragma unroll
            for (int ii = 0; ii < 8; ++ii) raw[ii] = *(const uint4*)(U + (size_t)(m0 + ii) * NP + C_X + cc);
            asm volatile("s_waitcnt vmcnt(0)" ::: "memory");
#pragma unroll
            for (int ii = 0; ii < 8; ++ii) { float cur[8], o[8]; UNPACK8(raw[ii], cur);
#pragma unroll
                for (int e = 0; e < 8; ++e) { o[e] = siluf(cb[e] + cw[0][e] * w0[e] + cw[1][e] * w1[e] + cw[2][e] * w2[e] + cw[3][e] * cur[e]); w0[e] = w1[e]; w1[e] = w2[e]; w2[e] = cur[e]; }
                *(u32x4*)(U + (size_t)(m0 + ii) * NP + C_X + cc) = PACK8(o); }
        }
    }
#undef CV_LOAD
}
#ifndef PROBE_REP_GEMM
#define PROBE_REP_GEMM 1
#endif
constexpr int LDS_BYTES = 131072 + 16;
__global__ void __launch_bounds__(512) mega(Params p, int ph_lo, int ph_hi) {
    extern __shared__ __attribute__((aligned(16))) unsigned char smem[];
    cg::grid_group grid = cg::this_grid();
    LAS unsigned char* lds = (LAS unsigned char*)smem;
    unsigned char* ws = p.ws;
#define G lgdim()
#define bx lbid()
    bf16_t* U = (bf16_t*)(ws + OFF_U); bf16_t* Tb = (bf16_t*)(ws + OFF_T);
    if (threadIdx.x < 4) ((LAS unsigned*)(lds + 131072))[threadIdx.x] = 0u;
    __syncthreads();
    XcdBarrier xbar = xcd_barrier_post((unsigned*)(ws + OFF_BAR), (volatile LAS unsigned*)(lds + 131072));
    int ph = 0;
#ifndef PHMASK
#define PHMASK 0xFFF
#endif
#define PHASE_BEGIN(k) if (((PHMASK >> (k)) & 1) && ph >= ph_lo && ph < ph_hi) {
#define PHASE_END   if (ph + 1 < ph_hi) { if (ph == 0) grid.sync(); else xcd_barrier(xbar); } } ++ph;
    PHASE_BEGIN(0) phase0(p, smem); PHASE_END
    for (int l = 0; l < 2; ++l) {
        unsigned char* wl = ws + (size_t)l * W_STRIDE;
        const bf16_t* Xbin = (const bf16_t*)(ws + OFF_XB);
        PHASE_BEGIN(1) { pg8::Gemm g{Xbin, (const bf16_t*)(wl + W_IN), MT, NP, DM, DM}; pg8::StaticOrder S; S.init(MT, NP, G, bx); EpiU E{U, (float*)(ws + OFF_DT)}; for (int rep = 0; rep < PROBE_REP_GEMM; ++rep) pg8::gemm_phase(lds, g, S, E); } PHASE_END
        PHASE_BEGIN(2) prep_phase(p, l); conv_phase(p, l, xbar);
                         { int kl = KLORA; asm volatile("" : "+s"(kl)); pg8::Gemm g{(const bf16_t*)(ws + OFF_AP), (const bf16_t*)(wl + W_LR), MT, NLORA, kl, kl}; pg8::StaticOrder S; S.init(MT, NLORA, G, bx);
                      EpiLora E{(bf16_t*)(ws + OFF_LOR), p.in[I_W0] + (size_t)l * DM, p.in[I_A0] + (size_t)l * DM}; for (int rep = 0; rep < PROBE_REP_GEMM; ++rep) pg8::gemm_phase(lds, g, S, E); } PHASE_END
        PHASE_BEGIN(4) scan_phase(p, l, smem); PHASE_END
        PHASE_BEGIN(5) post_phase(p, l); PHASE_END
        PHASE_BEGIN(6) { pg8::StaticOrder S; S.init(MTAIL0, DM, G, bx);
                      { pg8::Gemm g{U, (const bf16_t*)(wl + W_PS), MTAIL0, DM, DI, NP}; EpiMerge<0> E{Tb, nullptr, U}; for (int rep = 0; rep < PROBE_REP_GEMM; ++rep) { pg8::gemm_phase(lds, g, S, E); gemm_tail(g.A, g.lda, g.Bt, DI, E, smem); } }
                      { pg8::Gemm g{U + C_R, (const bf16_t*)(wl + W_PR), MTAIL0, DM, DM, NP}; EpiMerge<1> E{Tb, (bf16_t*)(ws + OFF_MG), U}; for (int rep = 0; rep < PROBE_REP_GEMM; ++rep) { pg8::gemm_phase(lds, g, S, E); gemm_tail(g.A, g.lda, g.Bt, DM, E, smem); } } } PHASE_END
        PHASE_BEGIN(7) { pg8::Gemm g{(const bf16_t*)(ws + OFF_MG), (const bf16_t*)(wl + W_WO), MTAIL0, DM, DM, DM}; pg8::StaticOrder S; S.init(MTAIL0, DM, G, bx); EpiResid E{Tb, Xbin}; for (int rep = 0; rep < PROBE_REP_GEMM; ++rep) { pg8::gemm_phase(lds, g, S, E); gemm_tail(g.A, g.lda, g.Bt, DM, E, smem); } } PHASE_END
        PHASE_BEGIN(8) ln_phase(p, Tb, p.in[I_LN1G] + (size_t)l * DM, p.in[I_LN1B] + (size_t)l * DM, (bf16_t*)(ws + OFF_X1B), false); PHASE_END
        PHASE_BEGIN(9) { pg8::Gemm g{(const bf16_t*)(ws + OFF_X1B), (const bf16_t*)(wl + W_FI), MT, 2 * DFF, DM, DM}; pg8::StaticOrder S; S.init(MT, 2 * DFF, G, bx); EpiSwiglu E{(bf16_t*)(ws + OFF_ACT)}; for (int rep = 0; rep < PROBE_REP_GEMM; ++rep) pg8::gemm_phase(lds, g, S, E); } PHASE_END
        PHASE_BEGIN(10) { pg8::Gemm g{(const bf16_t*)(ws + OFF_ACT), (const bf16_t*)(wl + W_FO), MTAIL0, DM, DFF, DFF}; pg8::StaticOrder S; S.init(MTAIL0, DM, G, bx); EpiResid E{Tb, (const bf16_t*)(ws + OFF_X1B)}; for (int rep = 0; rep < PROBE_REP_GEMM; ++rep) { pg8::gemm_phase(lds, g, S, E); gemm_tail(g.A, g.lda, g.Bt, DFF, E, smem); } } PHASE_END
        PHASE_BEGIN(11) ln_phase(p, Tb, p.in[I_LN2G] + (size_t)l * DM, p.in[I_LN2B] + (size_t)l * DM, (bf16_t*)(ws + OFF_XB), l == 1); PHASE_END
    }
}
#undef G
#undef bx
constexpr int N_PHASES = 21;

extern "C" void kernel_launch(void* const* d_in, const int* in_sizes, int n_in, void* d_out, int out_size, void* d_ws, size_t ws_size, hipStream_t stream) {
    static int grid_blocks = 0;
    if (!grid_blocks) {
        int dev = 0, cus = 0, per_cu = 0;
        hipGetDevice(&dev); hipDeviceGetAttribute(&cus, hipDeviceAttributeMultiprocessorCount, dev);
        hipFuncSetAttribute((const void*)mega, hipFuncAttributeMaxDynamicSharedMemorySize, LDS_BYTES);
        hipOccupancyMaxActiveBlocksPerMultiprocessor(&per_cu, (const void*)mega, 512, LDS_BYTES);
        if (per_cu < 1) per_cu = 1;
        grid_blocks = cus * per_cu;
        if (ws_size < 947 * MiB) fprintf(stderr, "kernel_launch: workspace too small: %zu\n", ws_size);
    }
    hipMemsetAsync((char*)d_ws + OFF_BAR, 0, XCD_BAR_WORDS * 4, stream);
    Params p{};
    for (int i = 0; i < N_IN; ++i) p.in[i] = (const float*)d_in[i];
    p.out = (float*)d_out; p.ws = (unsigned char*)d_ws;
    int lo = 0, hi = N_PHASES;
    void* args[] = {&p, &lo, &hi};
    hipError_t e = hipLaunchCooperativeKernel((const void*)mega, dim3(grid_blocks), dim3(512), args, LDS_BYTES, stream);
    if (e != hipSuccess) fprintf(stderr, "cooperative launch failed: %s (grid %d)\n", hipGetErrorString(e), grid_blocks);
}
```

```cpp
#include <hip/hip_runtime.h>
#include <hip/hip_cooperative_groups.h>
#include <cstdio>
namespace cg = cooperative_groups;

__device__ __forceinline__ int ltid() { int t = threadIdx.x; asm volatile("" : "+v"(t)); return t; }
__device__ __forceinline__ int lbid() { int t = blockIdx.x; asm volatile("" : "+s"(t)); return t; }
__device__ __forceinline__ int lgdim() { int t = gridDim.x; asm volatile("" : "+s"(t)); return t; }
namespace pg8 {
#define PG8_LAS __attribute__((address_space(3)))
typedef unsigned short bf16_t;
typedef short bf16x8 __attribute__((ext_vector_type(8)));
typedef float f32x4 __attribute__((ext_vector_type(4)));
typedef unsigned u32x4 __attribute__((ext_vector_type(4)));
constexpr int BM = 256, BK = 64, HALF = 128, HTB = HALF * BK * 2  , STAGE_BYTES = 8 * HTB, NXCD = 8, WGM = 8;

__host__ __device__ __forceinline__ int lds_byte(int r, int c) { const int st = (r >> 4) * 2 + (c >> 5), rr = r & 15, cc = c & 31, ob = rr * 64 + cc * 2; return st * 1024 + (ob ^ (((ob >> 9) & 1) << 5)); }
__host__ __device__ __forceinline__ void stage_rc(int b, int& R, int& C) { const int st = b / 1024, sb = b % 1024, swz = sb ^ (((sb >> 9) & 1) << 5); R = (st >> 1) * 16 + swz / 64; C = (st & 1) * 32 + (swz % 64) / 2; }
__host__ __device__ __forceinline__ int perm32(int rho) { const int n = rho >> 4, i = rho & 15; return 8 * (i >> 2) + 4 * n + (i & 3); }

struct Unit { int pm, pn; };
struct Gemm { const bf16_t* A; const bf16_t* Bt; int M, N, K; int lda; };

struct StaticOrder {
    int nM, nN, nwg, G, c;
    __host__ __device__ void init(int M, int N, int G_, int c_) { nM = M / BM; nN = N / BM; nwg = nM * nN; G = G_; c = c_; }
    __host__ __device__ bool next(int i, Unit& u) const {
        const long L = (long)i * G + c; if (L >= nwg) return false;
        int wgid = (int)L; { const int q = nwg / NXCD, r = nwg % NXCD, xcd = wgid % NXCD, off = wgid / NXCD; wgid = (xcd < r ? xcd * (q + 1) : r * (q + 1) + (xcd - r) * q) + off; }
        const int nig = WGM * nN, gid = wgid / nig, fm = gid * WGM, gsz = (nM - fm) < WGM ? (nM - fm) : WGM;
        u.pm = fm + ((wgid % nig) % gsz); u.pn = (wgid % nig) / gsz; return true;
    }
    __device__ __forceinline__ void a_ready(const Unit&) const {}
    __device__ __forceinline__ void done(const Unit&) const {}
};
__device__ __forceinline__ unsigned cvt_pk_bf16(float lo, float hi) { unsigned r; asm volatile("v_cvt_pk_bf16_f32 %0, %1, %2" : "=v"(r) : "v"(lo), "v"(hi)); return r; }
template <class Epi, class Sched>
__device__ __forceinline__ void gemm_phase(PG8_LAS unsigned char* lds, const Gemm g, const Sched& S, const Epi& E) {
    const int tid = ltid(), wid = __builtin_amdgcn_readfirstlane(tid >> 6), lane = tid & 63, wr = wid >> 2, wc = wid & 3, fr = lane & 15, fq = lane >> 4;
    const int K = g.K, nt = K / BK;
    unsigned voffA[2], voffB[2];
#pragma unroll
    for (int i = 0; i < 2; ++i) { int R, C; stage_rc(tid * 16 + i * 8192, R, C); const int Rb = Epi::PERM ? ((R & ~31) + perm32(R & 31)) : R;
        voffA[i] = (unsigned)(R * g.lda + C) * 2u; voffB[i] = (unsigned)(Rb * K + C) * 2u; }
    const size_t kstep = (size_t)(BK * 2);
    const size_t hstep = (size_t)HALF * K * 2;
    const size_t tstep = 2 * hstep;
    const size_t hstepA = (size_t)HALF * g.lda * 2, tstepA = 2 * hstepA;
    const unsigned ldsw = (unsigned)wid * 1024u;
    const int aoff = lds_byte(wr * 64 + fr, fq * 8), boff = lds_byte(wc * 32 + fr, fq * 8);
#define PG8_SA(b, h) (((b) * 2 + (h)) * HTB)
#define PG8_SB(b, h) ((4 + (b) * 2 + (h)) * HTB)
#define PG8_STAGE(bufoff, gbase, voff) do { _Pragma("unroll") for (int _i = 0; _i < 2; ++_i) \
        __builtin_amdgcn_global_load_lds((const unsigned*)((const char*)(gbase) + (voff)[_i]), (PG8_LAS unsigned*)(lds + (bufoff) + ldsw + _i * 8192), 16, 0, 0); } while (0)
#define PG8_LDA(dst, b, h) do { _Pragma("unroll") for (int m = 0; m < 4; ++m) _Pragma("unroll") for (int k = 0; k < 2; ++k) dst[m][k] = *(const PG8_LAS bf16x8*)(lds + PG8_SA(b, h) + aoff + m * 2048 + k * 1024); } while (0)
#define PG8_LDB(dst, b, h) do { _Pragma("unroll") for (int n = 0; n < 2; ++n) _Pragma("unroll") for (int k = 0; k < 2; ++k) dst[n][k] = *(const PG8_LAS bf16x8*)(lds + PG8_SB(b, h) + boff + n * 2048 + k * 1024); } while (0)
#define PG8_MMA(ai, bj, At, Bt) do { __builtin_amdgcn_s_setprio(1); _Pragma("unroll") for (int m = 0; m < 4; ++m) _Pragma("unroll") for (int n = 0; n < 2; ++n) _Pragma("unroll") for (int k = 0; k < 2; ++k) \
        acc[ai][bj][m][n] = __builtin_amdgcn_mfma_f32_16x16x32_bf16(Bt[n][k], At[m][k], acc[ai][bj][m][n], 0, 0, 0); __builtin_amdgcn_s_setprio(0); } while (0)
#define PG8_WAIT_V(n) asm volatile("s_waitcnt vmcnt(" #n ")" ::: "memory")
#define PG8_WAIT_L(n) asm volatile("s_waitcnt lgkmcnt(" #n ")" ::: "memory")
#define PG8_BAR __builtin_amdgcn_s_barrier()
#define PG8_SCHED __builtin_amdgcn_sched_barrier(0)
    Unit cur, nxt; int ui = 0;
    if (!S.next(0, cur)) return;
    f32x4 acc[2][2][4][2];
#pragma unroll
    for (int a = 0; a < 2; ++a)
#pragma unroll
        for (int b = 0; b < 2; ++b)
#pragma unroll
            for (int m = 0; m < 4; ++m)
#pragma unroll
                for (int n = 0; n < 2; ++n) acc[a][b][m][n] = (f32x4){0.f, 0.f, 0.f, 0.f};
    bf16x8 At[4][2], B0[2][2], B1[2][2];
    const char* cA = (const char*)g.A + (size_t)cur.pm * tstepA; const char* cB = (const char*)g.Bt + (size_t)cur.pn * tstep;
    S.a_ready(cur);
    PG8_STAGE(PG8_SB(0, 0), cB, voffB); PG8_STAGE(PG8_SA(0, 0), cA, voffA); PG8_STAGE(PG8_SB(0, 1), cB + hstep, voffB); PG8_STAGE(PG8_SA(0, 1), cA + hstepA, voffA);
    if (wr == 1) PG8_BAR;
    PG8_WAIT_V(4); PG8_BAR;
    PG8_STAGE(PG8_SB(1, 0), cB + kstep, voffB); PG8_STAGE(PG8_SA(1, 0), cA + kstep, voffA); PG8_STAGE(PG8_SB(1, 1), cB + hstep + kstep, voffB);
    PG8_WAIT_V(6); PG8_BAR;
    for (;;) {
        const bool has_next = S.next(ui + 1, nxt);
        const char* nA = has_next ? (const char*)g.A + (size_t)nxt.pm * tstepA : cA; const char* nB = has_next ? (const char*)g.Bt + (size_t)nxt.pn * tstep : cB;
        for (int t = 0; t < nt; t += 2) {
            const bool last = (t == nt - 2);
            const char* a1 = cA + (size_t)(t + 1) * kstep;
            const char* a2 = last ? nA : cA + (size_t)(t + 2) * kstep; const char* b2 = last ? nB : cB + (size_t)(t + 2) * kstep;
            const char* a3 = a2 + kstep; const char* b3 = b2 + kstep;
            if (last && has_next) S.a_ready(nxt);
            PG8_LDB(B0, 0, 0); PG8_SCHED; PG8_LDA(At, 0, 0); PG8_STAGE(PG8_SA(1, 1), a1 + hstepA, voffA);
            PG8_WAIT_L(8); PG8_BAR; PG8_WAIT_L(0); PG8_MMA(0, 0, At, B0); PG8_BAR; PG8_SCHED;
            PG8_LDB(B1, 0, 1); PG8_STAGE(PG8_SB(0, 0), b2, voffB);
            PG8_BAR; PG8_WAIT_L(0); PG8_MMA(0, 1, At, B1); PG8_BAR;
            PG8_LDA(At, 0, 1); PG8_STAGE(PG8_SA(0, 0), a2, voffA);
            PG8_BAR; PG8_WAIT_L(0); PG8_MMA(1, 0, At, B0); PG8_BAR; PG8_SCHED;
            PG8_STAGE(PG8_SB(0, 1), b2 + hstep, voffB);
            PG8_WAIT_V(6); PG8_BAR; PG8_MMA(1, 1, At, B1); PG8_BAR;
            PG8_LDB(B0, 1, 0); PG8_SCHED; PG8_LDA(At, 1, 0); PG8_STAGE(PG8_SA(0, 1), a2 + hstepA, voffA);
            PG8_WAIT_L(8); PG8_BAR; PG8_WAIT_L(0); PG8_MMA(0, 0, At, B0); PG8_BAR; PG8_SCHED;
            PG8_LDB(B1, 1, 1); PG8_STAGE(PG8_SB(1, 0), b3, voffB);
            PG8_BAR; PG8_WAIT_L(0); PG8_MMA(0, 1, At, B1); PG8_BAR;
            PG8_LDA(At, 1, 1); PG8_STAGE(PG8_SA(1, 0), a3, voffA);
            PG8_BAR; PG8_WAIT_L(0); PG8_MMA(1, 0, At, B0); PG8_BAR; PG8_SCHED;
            PG8_STAGE(PG8_SB(1, 1), b3 + hstep, voffB);
            PG8_WAIT_V(6); PG8_BAR; PG8_MMA(1, 1, At, B1); PG8_BAR;
        }
        if constexpr (!Epi::AFTER_DRAIN) { E(acc, cur, wr, wc, fr, fq); S.done(cur); }
        if (!has_next) break;
#pragma unroll
        for (int a = 0; a < 2; ++a)
#pragma unroll
            for (int b = 0; b < 2; ++b)
#pragma unroll
                for (int m = 0; m < 4; ++m)
#pragma unroll
                    for (int n = 0; n < 2; ++n) acc[a][b][m][n] = (f32x4){0.f, 0.f, 0.f, 0.f};
        cur = nxt; cA = nA; cB = nB; ++ui;
    }
    PG8_WAIT_V(0);
    if (wr == 0) PG8_BAR;
    PG8_BAR;
    if constexpr (Epi::AFTER_DRAIN) { E.fused(acc, cur, wr, wc, fr, fq, lds, wid, lane); S.done(cur); }
#undef PG8_SA
#undef PG8_SB
#undef PG8_STAGE
#undef PG8_LDA
#undef PG8_LDB
#undef PG8_MMA
#undef PG8_WAIT_V
#undef PG8_WAIT_L
#undef PG8_BAR
#undef PG8_SCHED
}
}

typedef unsigned short bf16_t;
using pg8::f32x4; using pg8::bf16x8; using pg8::u32x4; using pg8::Unit;
typedef unsigned u32x2 __attribute__((ext_vector_type(2)));
typedef float f32x2 __attribute__((ext_vector_type(2)));
#define LAS __attribute__((address_space(3)))
constexpr int DM = 1024, NB = 8, SEQ = 2048, NMETA = 16, LP = SEQ + NMETA, MP = NB * LP, NS = 128, MT = MP + NS;
constexpr int DI = 2048, NH = 32, CD = 3072, RC = 3328, NIN = 10528, NP = 10752, DFF = 2816, NLORA = 3072, KLORA = 256;
constexpr int C_X = 2048, C_DT = 5120, C_R = 5152, C_GS = 8480, C_GR = 9504;
constexpr float ALPHA = 1.4142135623730951f;
constexpr size_t MiB = 1u << 20;
constexpr size_t W_IN = 0, W_PS = 21 * MiB, W_PR = 25 * MiB, W_WO = 27 * MiB, W_FI = 29 * MiB, W_FO = 40 * MiB, W_LR = 46 * MiB, W_STRIDE = 48 * MiB;
constexpr size_t OFF_U = 96 * MiB, OFF_X = 438 * MiB, OFF_XB = 503 * MiB, OFF_LOR = 536 * MiB, OFF_T = OFF_LOR, OFF_X1B = OFF_LOR + 66 * MiB;
constexpr size_t OFF_O = 731 * MiB, OFF_MG = OFF_LOR + 33 * MiB, OFF_AP = 927 * MiB, OFF_DT = 936 * MiB, OFF_SSQ = 944 * MiB  , OFF_BON = 940 * MiB, OFF_ACT = OFF_U;
constexpr size_t OFF_BAR = 943 * MiB;
constexpr size_t OUT_YP = 0, OUT_YSM = OUT_YP + (size_t)NB * SEQ * DM, OUT_SSMP = OUT_YSM + (size_t)NS * DM, OUT_CONVP = OUT_SSMP + (size_t)2 * NB * NH * 64 * 128,
    OUT_WKVP = OUT_CONVP + (size_t)2 * NB * 3 * CD, OUT_SHP = OUT_WKVP + (size_t)2 * NB * 16 * 64 * 64, OUT_SSMS = OUT_SHP + (size_t)2 * NB * RC,
    OUT_CONVS = OUT_SSMS + (size_t)2 * NS * NH * 64 * 128, OUT_WKVS = OUT_CONVS + (size_t)2 * NS * 3 * CD, OUT_SHS = OUT_WKVS + (size_t)2 * NS * 16 * 64 * 64;
enum { I_XP = 0, I_XS, I_SSSM, I_SCONV, I_SWKV, I_SSHIFT, I_META, I_WIN, I_CONVW, I_CONVB, I_DTB, I_ALOG, I_DSKIP, I_SNW, I_PSSM, I_MU, I_W0, I_WLU, I_A0, I_ALU, I_GLU,
       I_KK, I_KA, I_RK, I_LNXG, I_LNXB, I_PRWKV, I_WOUT, I_LN1G, I_LN1B, I_WFI, I_WFO, I_LN2G, I_LN2B, N_IN };
struct Params { const float* in[N_IN]; float* out; unsigned char* ws; };

__device__ __forceinline__ float bf2f(bf16_t h) { return __uint_as_float(((unsigned)h) << 16); }
__device__ __forceinline__ bf16_t f2bf(float f) { unsigned u = __float_as_uint(f); u += 0x7FFFu + ((u >> 16) & 1u); return (bf16_t)(u >> 16); }
__device__ __forceinline__ float sigm(float x) { return 1.f / (1.f + __expf(-x)); }
__device__ __forceinline__ float siluf(float x) { return x / (1.f + __expf(-x)); }
__device__ __forceinline__ float softplusf(float x) { return fmaxf(x, 0.f) + log1pf(__expf(-fabsf(x))); }
__device__ __forceinline__ unsigned pk2(float a, float b) { return pg8::cvt_pk_bf16(a, b); }
#define UNPACK8(v, f) do { f[0] = __uint_as_float((v).x << 16); f[1] = __uint_as_float((v).x & 0xffff0000u); f[2] = __uint_as_float((v).y << 16); f[3] = __uint_as_float((v).y & 0xffff0000u); \
    f[4] = __uint_as_float((v).z << 16); f[5] = __uint_as_float((v).z & 0xffff0000u); f[6] = __uint_as_float((v).w << 16); f[7] = __uint_as_float((v).w & 0xffff0000u); } while (0)
#define PACK8(f) (u32x4){pk2(f[0], f[1]), pk2(f[2], f[3]), pk2(f[4], f[5]), pk2(f[6], f[7])}
__device__ __forceinline__ float dpp_x1(float x) { return __int_as_float(__builtin_amdgcn_update_dpp(0, __float_as_int(x), 0xB1, 0xF, 0xF, true)); }
__device__ __forceinline__ float dpp_x2(float x) { return __int_as_float(__builtin_amdgcn_update_dpp(0, __float_as_int(x), 0x4E, 0xF, 0xF, true)); }
__device__ __forceinline__ float dpp_hm(float x) { return __int_as_float(__builtin_amdgcn_update_dpp(0, __float_as_int(x), 0x141, 0xF, 0xF, true)); }
__device__ __forceinline__ float red8(float x) { x += dpp_x1(x); x += dpp_x2(x); x += dpp_hm(x); return x; }

__device__ __forceinline__ float red16(float x) { x = red8(x); x += __int_as_float(__builtin_amdgcn_update_dpp(0, __float_as_int(x), 0x140, 0xF, 0xF, true)); return x; }
__device__ __forceinline__ float prev_rc(const Params& p, const bf16_t* U, int l, int m, int rc) {
    if (m < MP) { const int t = m % LP; return t ? bf2f(U[(size_t)(m - 1) * NP + C_R + rc]) : 0.f; }
    return p.in[I_SSHIFT][((size_t)l * NS + (m - MP)) * RC + rc];
}

__device__ __forceinline__ void transpose_cvt(const float* __restrict__ src, int ldsrc, int K, bf16_t* __restrict__ dst, int Nd, int nvalid, int mode, float* tile, int& toff) {
    const int tid = ltid(), ntn = Nd / 256, ntk = K / 64, G = lgdim(), nt = ntn * ntk;
    for (int t = (lbid() + G - toff % G) % G; t < nt; t += G) {
        const int tn = t % ntn, tk = t / ntn, n0 = tn * 256, k0 = tk * 64;
        { const int n4 = tid & 63, kk = tid >> 6, r = n0 + n4 * 4; int col;
          if (mode == 0) col = r < nvalid ? r : -1; else { const int pn = r >> 8, hf = (r >> 7) & 1, c = r & 127; col = hf * DFF + pn * 128 + c; }
          f32x4 v[8];
#pragma unroll
          for (int ps = 0; ps < 8; ++ps) v[ps] = col >= 0 ? __builtin_nontemporal_load((const f32x4*)(src + (size_t)(k0 + ps * 8 + kk) * ldsrc + col)) : (f32x4){0.f, 0.f, 0.f, 0.f};
#pragma unroll
          for (int ps = 0; ps < 8; ++ps) *(f32x4*)(tile + (ps * 8 + kk) * 260 + n4 * 4) = v[ps]; }
        __syncthreads();
        { const int n = tid >> 1, kh = tid & 1;
#pragma unroll
          for (int q = 0; q < 4; ++q) { float v[8];
#pragma unroll
              for (int j = 0; j < 8; ++j) v[j] = tile[(kh * 32 + q * 8 + j) * 260 + n];
              *(u32x4*)(dst + (size_t)(n0 + n) * K + k0 + kh * 32 + q * 8) = PACK8(v); } }
        __syncthreads();
    }
    toff += nt;
}
__device__ __forceinline__ void phase0(const Params& p, unsigned char* smem) {
    float* tile = (float*)smem; unsigned char* ws = p.ws; const int tid = ltid(); int toff = 0;
    for (int l = 0; l < 2; ++l) {
        unsigned char* wl = ws + (size_t)l * W_STRIDE;
        transpose_cvt(p.in[I_WIN] + (size_t)l * DM * NIN, NIN, DM, (bf16_t*)(wl + W_IN), NP, NIN, 0, tile, toff);
        transpose_cvt(p.in[I_PSSM] + (size_t)l * DI * DM, DM, DI, (bf16_t*)(wl + W_PS), DM, DM, 0, tile, toff);
        transpose_cvt(p.in[I_PRWKV] + (size_t)l * DM * DM, DM, DM, (bf16_t*)(wl + W_PR), DM, DM, 0, tile, toff);
        transpose_cvt(p.in[I_WOUT] + (size_t)l * DM * DM, DM, DM, (bf16_t*)(wl + W_WO), DM, DM, 0, tile, toff);
        transpose_cvt(p.in[I_WFI] + (size_t)l * DM * 2 * DFF, 2 * DFF, DM, (bf16_t*)(wl + W_FI), 2 * DFF, 2 * DFF, 1, tile, toff);
        transpose_cvt(p.in[I_WFO] + (size_t)l * DFF * DM, DM, DFF, (bf16_t*)(wl + W_FO), DM, DM, 0, tile, toff);
        bf16_t* wlr = (bf16_t*)(wl + W_LR);
        for (int idx = lbid() * 512 + tid; idx < NLORA * (KLORA / 8); idx += lgdim() * 512) {
            const int ko = idx / NLORA, r = idx % NLORA, blk = r >> 10, c = r & 1023; float v[8];
#pragma unroll
            for (int j = 0; j < 8; ++j) { const int k = ko * 8 + j; float x = 0.f;
                if (blk == 0) { if (k < 64) x = p.in[I_WLU][((size_t)l * 64 + k) * DM + c]; }
                else if (blk == 1) { if (k >= 64 && k < 128) x = p.in[I_ALU][((size_t)l * 64 + (k - 64)) * DM + c]; }
                else { if (k >= 128) x = p.in[I_GLU][((size_t)l * 128 + (k - 128)) * DM + c]; }
                v[j] = x; }
            *(u32x4*)(wlr + (size_t)r * KLORA + ko * 8) = PACK8(v);
        }
    }
    bf16_t* Xb = (bf16_t*)(ws + OFF_XB);
    { const int nth = lgdim() * 512;
      for (int idx0 = lbid() * 512 + tid; idx0 < MT * (DM / 4); idx0 += 4 * nth) {
        f32x4 v[4];
#pragma unroll
        for (int r = 0; r < 4; ++r) { const int idx = idx0 + r * nth < MT * (DM / 4) ? idx0 + r * nth : idx0; const int m = idx >> 8, c4 = (idx & 255) * 4; const float* sp;
            if (m < MP) { const int b = m / LP, t = m % LP; sp = t < NMETA ? p.in[I_META] + (size_t)t * DM : p.in[I_XP] + ((size_t)b * SEQ + (t - NMETA)) * DM; } else sp = p.in[I_XS] + (size_t)(m - MP) * DM;
            v[r] = __builtin_nontemporal_load((const f32x4*)(sp + c4)); }
#pragma unroll
        for (int r = 0; r < 4; ++r) { const int idx = idx0 + r * nth; if (idx < MT * (DM / 4)) { const int m = idx >> 8, c4 = (idx & 255) * 4;
            *(u32x2*)(Xb + (size_t)m * DM + c4) = (u32x2){pk2(v[r][0], v[r][1]), pk2(v[r][2], v[r][3])}; } }
      } }
}

#define EPI_LOOP_AM for (int ai = 0; ai < 2; ++ai) for (int m = 0; m < 4; ++m)
struct EpiU {
    static constexpr bool PERM = true, AFTER_DRAIN = false; bf16_t* U; float* DTb;
    __device__ __forceinline__ void operator()(const f32x4 (&acc)[2][2][4][2], const Unit& u, int wr, int wc, int fr, int fq) const {
        const int row0 = u.pm * 256 + wr * 64 + fr, col0 = u.pn * 256 + wc * 32 + 8 * fq;
#pragma unroll
        for (int ai = 0; ai < 2; ++ai)
#pragma unroll
            for (int m = 0; m < 4; ++m) { bf16_t* rowp = U + (size_t)(row0 + ai * 128 + m * 16) * NP + col0;
#pragma unroll
                for (int bj = 0; bj < 2; ++bj) { const f32x4 v0 = acc[ai][bj][m][0], v1 = acc[ai][bj][m][1];
                    *(u32x4*)(rowp + bj * 128) = (u32x4){pk2(v0[0], v0[1]), pk2(v0[2], v0[3]), pk2(v1[0], v1[1]), pk2(v1[2], v1[3])}; } }
        if (u.pn == C_DT / 256 && wc == 0) {
#pragma unroll
            for (int ai = 0; ai < 2; ++ai)
#pragma unroll
                for (int m = 0; m < 4; ++m) { float* d = DTb + (size_t)(row0 + ai * 128 + m * 16) * 32 + 8 * fq; *(f32x4*)d = acc[ai][0][m][0]; *(f32x4*)(d + 4) = acc[ai][0][m][1]; }
        }
    }
};
struct EpiLora {
    static constexpr bool PERM = true, AFTER_DRAIN = false; bf16_t* LOR; const float* w0; const float* a0;
    __device__ __forceinline__ void operator()(const f32x4 (&acc)[2][2][4][2], const Unit& u, int wr, int wc, int fr, int fq) const {
        const int row0 = u.pm * 256 + wr * 64 + fr, col0 = u.pn * 256 + wc * 32 + 8 * fq, kind = u.pn >> 2;
        const bool sg = kind < 2; const float* bias = kind == 0 ? w0 + col0 : a0 + (col0 - 1024);
        f32x4 bv[2][2];
#pragma unroll
        for (int bj = 0; bj < 2; ++bj)
#pragma unroll
            for (int n = 0; n < 2; ++n) { bv[bj][n] = (f32x4){0.f, 0.f, 0.f, 0.f}; if (sg) bv[bj][n] = *(const f32x4*)(bias + bj * 128 + n * 4); }
#pragma unroll
        for (int ai = 0; ai < 2; ++ai)
#pragma unroll
            for (int m = 0; m < 4; ++m) { bf16_t* rowp = LOR + (size_t)(row0 + ai * 128 + m * 16) * NLORA + col0;
#pragma unroll
                for (int bj = 0; bj < 2; ++bj) { float o[8];
#pragma unroll
                    for (int n = 0; n < 2; ++n)
#pragma unroll
                        for (int j = 0; j < 4; ++j) { const float x = acc[ai][bj][m][n][j] + bv[bj][n][j]; const float y = sigm(x); o[n * 4 + j] = sg ? y : x; }
                    *(u32x4*)(rowp + bj * 128) = PACK8(o); } }
    }
};
template <int MODE> struct EpiMerge {
    static constexpr bool PERM = true, AFTER_DRAIN = false; bf16_t* T; bf16_t* MG; const bf16_t* U;
    __device__ __forceinline__ void elem(int row, int col, float v) const { const float gq = sigm(bf2f(U[(size_t)row * NP + (MODE == 0 ? C_GS : C_GR) + col])) * v;
        if (MODE == 0) T[(size_t)row * DM + col] = f2bf(gq); else MG[(size_t)row * DM + col] = f2bf(bf2f(T[(size_t)row * DM + col]) + gq); }
    __device__ __forceinline__ void operator()(const f32x4 (&acc)[2][2][4][2], const Unit& u, int wr, int wc, int fr, int fq) const {
        const int row0 = u.pm * 256 + wr * 64 + fr, col0 = u.pn * 256 + wc * 32 + 8 * fq;
#pragma unroll
        for (int ai = 0; ai < 2; ++ai)
#pragma unroll
            for (int m = 0; m < 4; ++m) { const size_t row = (size_t)(row0 + ai * 128 + m * 16);
#pragma unroll
                for (int bj = 0; bj < 2; ++bj) { const int col = col0 + bj * 128;
                    const uint4 gw = *(const uint4*)(U + row * NP + (MODE == 0 ? C_GS : C_GR) + col); float gf[8], o[8]; UNPACK8(gw, gf);
#pragma unroll
                    for (int n = 0; n < 2; ++n)
#pragma unroll
                        for (int j = 0; j < 4; ++j) o[n * 4 + j] = sigm(gf[n * 4 + j]) * acc[ai][bj][m][n][j];
                    if (MODE == 0) *(u32x4*)(T + row * DM + col) = PACK8(o);
                    else { const uint4 tw = *(const uint4*)(T + row * DM + col); float tf[8]; UNPACK8(tw, tf);
#pragma unroll
                        for (int e = 0; e < 8; ++e) o[e] += tf[e];
                        *(u32x4*)(MG + row * DM + col) = PACK8(o); } }
                asm volatile("" ::: "memory"); }
    }
};
struct EpiResid {
    static constexpr bool PERM = true, AFTER_DRAIN = false; bf16_t* T; const bf16_t* R;
    __device__ __forceinline__ void elem(int row, int col, float v) const { T[(size_t)row * DM + col] = f2bf(ALPHA * bf2f(R[(size_t)row * DM + col]) + v); }
    __device__ __forceinline__ void operator()(const f32x4 (&acc)[2][2][4][2], const Unit& u, int wr, int wc, int fr, int fq) const {
        const int row0 = u.pm * 256 + wr * 64 + fr, col0 = u.pn * 256 + wc * 32 + 8 * fq;
#pragma unroll
        for (int ai = 0; ai < 2; ++ai)
#pragma unroll
            for (int m = 0; m < 4; ++m) { const size_t off = (size_t)(row0 + ai * 128 + m * 16) * DM + col0;
#pragma unroll
                for (int bj = 0; bj < 2; ++bj) { const uint4 rw = *(const uint4*)(R + off + bj * 128); float rf[8], o[8]; UNPACK8(rw, rf);
#pragma unroll
                    for (int n = 0; n < 2; ++n)
#pragma unroll
                        for (int j = 0; j < 4; ++j) o[n * 4 + j] = rf[n * 4 + j] * ALPHA + acc[ai][bj][m][n][j];
                    *(u32x4*)(T + off + bj * 128) = PACK8(o); }
                asm volatile("" ::: "memory"); }
    }
};
struct EpiSwiglu {
    static constexpr bool PERM = true, AFTER_DRAIN = false; bf16_t* ACT;
    __device__ __forceinline__ void operator()(const f32x4 (&acc)[2][2][4][2], const Unit& u, int wr, int wc, int fr, int fq) const {
        const int row0 = u.pm * 256 + wr * 64 + fr, col0 = u.pn * 128 + wc * 32 + 8 * fq;
#pragma unroll
        for (int ai = 0; ai < 2; ++ai)
#pragma unroll
            for (int m = 0; m < 4; ++m) { float o[8];
#pragma unroll
                for (int n = 0; n < 2; ++n)
#pragma unroll
                    for (int j = 0; j < 4; ++j) o[n * 4 + j] = siluf(acc[ai][0][m][n][j]) * acc[ai][1][m][n][j];
                *(u32x4*)(ACT + (size_t)(row0 + ai * 128 + m * 16) * DFF + col0) = PACK8(o); }
    }
};

#define MFMA16(a, b, c) __builtin_amdgcn_mfma_f32_16x16x32_bf16((a), (b), (c), 0, 0, 0)

constexpr int MTAIL0 = 16384;
template <class Epi> __device__ __forceinline__ void gemm_tail(const bf16_t* __restrict__ A, int lda, const bf16_t* __restrict__ Bt, int K, const Epi& E, unsigned char* smem) {
    const int tid = ltid(), lane = tid & 63, w = tid >> 6, l15 = lane & 15, q4 = lane >> 4; float* part = (float*)smem;
    for (int u = lbid(); u < 256; u += lgdim()) {
        const int rbk = u >> 4, cb0 = (u & 15) * 4, ks = K >> 8;
        const bf16_t* ap = A + (size_t)(MTAIL0 + rbk * 16 + l15) * lda + (size_t)w * (K >> 3) + q4 * 8;
        const bf16_t* bp = Bt + (size_t)(cb0 * 16 + l15) * K + (size_t)w * (K >> 3) + q4 * 8;
        f32x4 acc[4];
#pragma unroll
        for (int b = 0; b < 4; ++b) acc[b] = (f32x4){0.f, 0.f, 0.f, 0.f};
#pragma unroll 4
        for (int k = 0; k < ks; ++k) { const bf16x8 a = *(const bf16x8*)(ap + k * 32);
#pragma unroll
            for (int b = 0; b < 4; ++b) { const bf16x8 bb = *(const bf16x8*)(bp + (size_t)b * 16 * K + k * 32); acc[b] = MFMA16(a, bb, acc[b]); } }
#pragma unroll
        for (int b = 0; b < 4; ++b)
#pragma unroll
            for (int jj = 0; jj < 4; ++jj) part[((w * 4 + b) * 4 + jj) * 64 + lane] = acc[b][jj];
        __syncthreads();
#pragma unroll
        for (int r = 0; r < 2; ++r) { const int o = tid + r * 512, b = o >> 8, e = o & 255, jj = e >> 6, ln = e & 63; float v = 0.f;
#pragma unroll
            for (int ww = 0; ww < 8; ++ww) v += part[((ww * 4 + b) * 4 + jj) * 64 + ln];
            E.elem(MTAIL0 + rbk * 16 + (ln >> 4) * 4 + jj, (cb0 + b) * 16 + (ln & 15), v); }
        __syncthreads();
    }
}
__device__ __forceinline__ float block_sum(float v, float* red, int tid) {
    v += __shfl_xor(v, 1); v += __shfl_xor(v, 2); v += __shfl_xor(v, 4); v += __shfl_xor(v, 8); v += __shfl_xor(v, 16); v += __shfl_xor(v, 32);
    __syncthreads();
    if ((tid & 63) == 0) red[tid >> 6] = v;
    __syncthreads();
    return ((red[0] + red[1]) + (red[2] + red[3])) + ((red[4] + red[5]) + (red[6] + red[7]));
}
#define WRED(v) do { v += __shfl_xor(v, 1); v += __shfl_xor(v, 2); v += __shfl_xor(v, 4); v += __shfl_xor(v, 8); v += __shfl_xor(v, 16); v += __shfl_xor(v, 32); } while (0)
__device__ __forceinline__ void ln_phase(const Params& p, const bf16_t* T, const float* g, const float* b, bf16_t* Xbo, bool fin) {
    const int tid = ltid(), lane = tid & 63, wv = tid >> 6;
    f32x4 gk[4], bk[4];
#pragma unroll
    for (int k = 0; k < 4; ++k) { gk[k] = *(const f32x4*)(g + k * 256 + lane * 4); bk[k] = *(const f32x4*)(b + k * 256 + lane * 4); }
    const int stride = lgdim() * 8;
    for (int m0 = lbid() * 8 + wv; m0 < MT; m0 += 2 * stride) {
        u32x2 tw[2][4];
#pragma unroll
        for (int r = 0; r < 2; ++r) { const int m = m0 + r * stride < MT ? m0 + r * stride : m0;
#pragma unroll
            for (int k = 0; k < 4; ++k) tw[r][k] = *(const u32x2*)(T + (size_t)m * DM + k * 256 + lane * 4); }
#pragma unroll
        for (int r = 0; r < 2; ++r) { const int m = m0 + r * stride; if (m < MT) {
            f32x4 v[4]; float s = 0.f;
#pragma unroll
            for (int k = 0; k < 4; ++k) { v[k] = (f32x4){__uint_as_float(tw[r][k].x << 16), __uint_as_float(tw[r][k].x & 0xffff0000u), __uint_as_float(tw[r][k].y << 16), __uint_as_float(tw[r][k].y & 0xffff0000u)}; s += (v[k][0] + v[k][1]) + (v[k][2] + v[k][3]); }
            WRED(s); const float mean = s * (1.f / DM); float q = 0.f;
#pragma unroll
            for (int k = 0; k < 4; ++k) { v[k] -= mean; q += (v[k][0] * v[k][0] + v[k][1] * v[k][1]) + (v[k][2] * v[k][2] + v[k][3] * v[k][3]); }
            WRED(q); const float rs = rsqrtf(q * (1.f / DM) + 1e-5f);
            float* dst = nullptr;
            if (fin) { if (m >= MP) dst = p.out + OUT_YSM + (size_t)(m - MP) * DM; else { const int bb = m / LP, t = m % LP; if (t >= NMETA) dst = p.out + OUT_YP + ((size_t)bb * SEQ + (t - NMETA)) * DM; } }
#pragma unroll
            for (int k = 0; k < 4; ++k) { const f32x4 o = v[k] * rs * gk[k] + bk[k];
                if (dst) __builtin_nontemporal_store(o, (f32x4*)(dst + k * 256 + lane * 4));
                if (!fin) *(u32x2*)(Xbo + (size_t)m * DM + k * 256 + lane * 4) = (u32x2){pk2(o[0], o[1]), pk2(o[2], o[3])}; } } }
    }
}
__device__ __forceinline__ void prep_phase(const Params& p, int l) {
    const int tid = ltid(), lane = tid & 63, wv = tid >> 6; const bf16_t* U = (const bf16_t*)(p.ws + OFF_U); bf16_t* AP = (bf16_t*)(p.ws + OFF_AP);
    const f32x4 mu4 = *(const f32x4*)(p.in[I_MU] + (size_t)l * RC + 3072 + lane * 4);
    for (int m = lbid() * 8 + wv; m < MT; m += lgdim() * 8) {
        const bf16_t* ur = U + (size_t)m * NP;
        { const int rc = 3072 + lane * 4; const u32x2 uw = *(const u32x2*)(ur + C_R + rc);
          float u[4] = {__uint_as_float(uw.x << 16), __uint_as_float(uw.x & 0xffff0000u), __uint_as_float(uw.y << 16), __uint_as_float(uw.y & 0xffff0000u)}; float pv[4];
          if (m < MP) { if (m % LP) { const u32x2 pw = *(const u32x2*)(ur - NP + C_R + rc); pv[0] = __uint_as_float(pw.x << 16); pv[1] = __uint_as_float(pw.x & 0xffff0000u); pv[2] = __uint_as_float(pw.y << 16); pv[3] = __uint_as_float(pw.y & 0xffff0000u); }
                        else { pv[0] = pv[1] = pv[2] = pv[3] = 0.f; } }
          else { const f32x4 q = *(const f32x4*)(p.in[I_SSHIFT] + ((size_t)l * NS + (m - MP)) * RC + rc); pv[0] = q[0]; pv[1] = q[1]; pv[2] = q[2]; pv[3] = q[3]; }
          float o[4];
#pragma unroll
          for (int j = 0; j < 4; ++j) { const float sv = u[j] + (pv[j] - u[j]) * mu4[j]; o[j] = lane < 16 ? tanhf(sv) : (lane < 32 ? sv : sigm(sv)); }
          *(u32x2*)(AP + (size_t)m * KLORA + lane * 4) = (u32x2){pk2(o[0], o[1]), pk2(o[2], o[3])}; }
        if (m < MP) { const int b = m / LP, t = m % LP;
            if (t >= LP - 3) { float* d = p.out + OUT_CONVP + (((size_t)l * NB + b) * 3 + (t - (LP - 3))) * CD; _Pragma("unroll 4") for (int c = lane; c < CD; c += 64) d[c] = bf2f(ur[C_X + c]); }
            if (t == LP - 1) { float* d = p.out + OUT_SHP + ((size_t)l * NB + b) * RC; _Pragma("unroll 4") for (int c = lane; c < RC; c += 64) d[c] = bf2f(ur[C_R + c]); }
        } else { const int sx = m - MP; float* d = p.out + OUT_CONVS + ((size_t)l * NS + sx) * 3 * CD; const float* sc = p.in[I_SCONV] + ((size_t)l * NS + sx) * 3 * CD;
            _Pragma("unroll 2") for (int c = lane; c < CD; c += 64) { d[c] = sc[CD + c]; d[CD + c] = sc[2 * CD + c]; d[2 * CD + c] = bf2f(ur[C_X + c]); }
            float* d2 = p.out + OUT_SHS + ((size_t)l * NS + sx) * RC; _Pragma("unroll 4") for (int c = lane; c < RC; c += 64) d2[c] = bf2f(ur[C_R + c]); }
    }
}
__device__ __forceinline__ void post_phase(const Params& p, int l) {
    const int tid = ltid(), lane = tid & 63, wv = tid >> 6; bf16_t* U = (bf16_t*)(p.ws + OFF_U);
    const bf16_t* O = (const bf16_t*)(p.ws + OFF_O); const bf16_t* LOR = (const bf16_t*)(p.ws + OFF_LOR); const float* BON = (const float*)(p.ws + OFF_BON);
    const float* ssqp = (const float*)(p.ws + OFF_SSQ);
    const float* nwp = p.in[I_SNW] + (size_t)l * DI + lane * 8; const float* lgp = p.in[I_LNXG] + l * DM + lane * 16; const float* lbp = p.in[I_LNXB] + l * DM + lane * 16; const float* mvp = p.in[I_MU] + (size_t)l * RC + 2048 + lane * 16;
    f32x4 nwr[4][2], lgr[4], lbr[4], mvr[4];
#pragma unroll
    for (int k = 0; k < 4; ++k) { nwr[k][0] = *(const f32x4*)(nwp + k * 512); nwr[k][1] = *(const f32x4*)(nwp + k * 512 + 4); lgr[k] = *(const f32x4*)(lgp + k * 4); lbr[k] = *(const f32x4*)(lbp + k * 4); mvr[k] = *(const f32x4*)(mvp + k * 4); }
    for (int m = lbid() * 8 + wv; m < MT; m += lgdim() * 8) {
        f32x4 sq4; { float pv = lane < 32 ? ssqp[(size_t)lane * MT + m] : 0.f; pv = red8(pv); sq4[0] = __shfl(pv, 0); sq4[1] = __shfl(pv, 8); sq4[2] = __shfl(pv, 16); sq4[3] = __shfl(pv, 24); }
#pragma unroll
        for (int k = 0; k < 4; ++k) { bf16_t* y = U + (size_t)m * NP + k * 512 + lane * 8; const uint4 w = *(const uint4*)y; float f[8]; UNPACK8(w, f);
            const float rs = rsqrtf(sq4[k] * (1.f / 512.f) + 1e-5f); const f32x4 n0 = nwr[k][0], n1 = nwr[k][1];
#pragma unroll
            for (int e = 0; e < 4; ++e) { f[e] *= rs * n0[e]; f[4 + e] *= rs * n1[e]; }
            *(u32x4*)y = PACK8(f); }
        { f32x4 o[4]; float s = 0.f;
          { const bf16_t* op = O + (size_t)m * DM + lane * 16; const uint4 oa = *(const uint4*)op, ob = *(const uint4*)(op + 8); float of[16]; UNPACK8(oa, of); float* of2 = of + 8; UNPACK8(ob, of2);
#pragma unroll
            for (int k = 0; k < 4; ++k) { o[k] = (f32x4){of[k * 4], of[k * 4 + 1], of[k * 4 + 2], of[k * 4 + 3]}; s += (o[k][0] + o[k][1]) + (o[k][2] + o[k][3]); } }
          s += __shfl_xor(s, 1); s += __shfl_xor(s, 2); const float mu = s * (1.f / 64.f); float q = 0.f;
#pragma unroll
          for (int k = 0; k < 4; ++k) { o[k] -= mu; q += (o[k][0] * o[k][0] + o[k][1] * o[k][1]) + (o[k][2] * o[k][2] + o[k][3] * o[k][3]); }
          q += __shfl_xor(q, 1); q += __shfl_xor(q, 2); const float rs = rsqrtf(q * (1.f / 64.f) + 64e-5f);
          const bf16_t* uv = U + (size_t)m * NP + C_R + 2048 + lane * 16; float u[16], pv[16];
          { const uint4 a = *(const uint4*)uv, b = *(const uint4*)(uv + 8); UNPACK8(a, u); float* u2 = u + 8; UNPACK8(b, u2); }
          if (m < MP) { if (m % LP) { const uint4 a = *(const uint4*)(uv - NP), b = *(const uint4*)(uv - NP + 8); UNPACK8(a, pv); float* p2 = pv + 8; UNPACK8(b, p2); }
                        else {
#pragma unroll
                            for (int e = 0; e < 16; ++e) pv[e] = 0.f; } }
          else { const float* sh = p.in[I_SSHIFT] + ((size_t)l * NS + (m - MP)) * RC + 2048 + lane * 16;
#pragma unroll
              for (int k = 0; k < 4; ++k) { const f32x4 t = *(const f32x4*)(sh + k * 4); pv[k * 4] = t[0]; pv[k * 4 + 1] = t[1]; pv[k * 4 + 2] = t[2]; pv[k * 4 + 3] = t[3]; } }
          const float bo = BON[(size_t)m * 16 + (lane >> 2)]; float r[16];
          float ggv[16]; { const bf16_t* gp = LOR + (size_t)m * NLORA + 2048 + lane * 16; const uint4 a = *(const uint4*)gp, b = *(const uint4*)(gp + 8); UNPACK8(a, ggv); float* g2 = ggv + 8; UNPACK8(b, g2); }
#pragma unroll
          for (int k = 0; k < 4; ++k) { const f32x4 gg = (f32x4){ggv[k * 4], ggv[k * 4 + 1], ggv[k * 4 + 2], ggv[k * 4 + 3]}, lg = lgr[k], lb = lbr[k], mv = mvr[k];
#pragma unroll
              for (int j = 0; j < 4; ++j) { const int e = k * 4 + j; const float v = u[e] + (pv[e] - u[e]) * mv[j]; r[e] = (o[k][j] * rs * lg[j] + lb[j] + bo * v) * gg[j]; } }
          bf16_t* yr = U + (size_t)m * NP + C_R + lane * 16;     float* r2 = r + 8; *(u32x4*)yr = PACK8(r); *(u32x4*)(yr + 8) = PACK8(r2); }
    }
}

__device__ __forceinline__ void ssd_unit(const Params& p, int l, int rowbase, int h, float* __restrict__ hout, unsigned char* smem, bool dry = false) {
    const int tid = ltid(), lane = tid & 63, w = tid >> 6, g = h >> 3, l15 = lane & 15, q4 = lane >> 4;
    bf16_t* Cs = (bf16_t*)smem;
    bf16_t* Bs = Cs + 64 * 136;
    bf16_t* BTw = Bs + 64 * 136;
    bf16_t* XT = BTw + 128 * 72;
    bf16_t* Ms = XT + 64 * 72;
    bf16_t* Hs = Ms + 64 * 72;
    bf16_t* Xs = Hs + 64 * 136;
    bf16_t* Zs = Xs + 64 * 72;
    float* acum = (float*)(Zs + 64 * 72);
    float* dtv = acum + 64;
    bf16_t* Ys = (bf16_t*)(dtv + 64);
    float* e1 = (float*)(Ys + 64 * 72);
    float* e2 = e1 + 64;
    bf16_t* U = (bf16_t*)(p.ws + OFF_U); const float* DTb = (const float*)(p.ws + OFF_DT);
    float* ssqp = (float*)(p.ws + OFF_SSQ) + (size_t)h * MT;
    const float av = -__expf(p.in[I_ALOG][l * NH + h]), dtb = p.in[I_DTB][l * NH + h], Dk = p.in[I_DSKIP][l * NH + h];
    f32x4 hacc[4];
#pragma unroll
    for (int pt = 0; pt < 4; ++pt)
#pragma unroll
        for (int jj = 0; jj < 4; ++jj) { hacc[pt][jj] = 0.f; Hs[(pt * 16 + q4 * 4 + jj) * 136 + w * 16 + l15] = 0; }
    constexpr int T = LP, nch = (T + 63) >> 6, pad = nch * 64 - T;
    const int xi = tid >> 3, xo = tid & 7;
    const int bi = tid >> 4, bo = tid & 15;
    uint4 px, pz, pb0, pb1, pc0, pc1; float pdt;
#define SSD_PREFETCH(c_) do { const int _tb = (c_) * 64 - pad; const uint4 _z4 = make_uint4(0u, 0u, 0u, 0u); \
        { const int _t = _tb + xi; px = _z4; pz = _z4; if (_t >= 0) { { const u32x4 _a = __builtin_nontemporal_load((const u32x4*)(U + (size_t)(rowbase + _t) * NP + C_X + h * 64 + xo * 8)), _b = __builtin_nontemporal_load((const u32x4*)(U + (size_t)(rowbase + _t) * NP + h * 64 + xo * 8)); px = make_uint4(_a.x, _a.y, _a.z, _a.w); pz = make_uint4(_b.x, _b.y, _b.z, _b.w); }     } } \
        { const int _t = _tb + bi; pb0 = _z4; pc0 = _z4; if (_t >= 0) { const bf16_t* _s = U + (size_t)(rowbase + _t) * NP + C_X + 2048 + g * 128 + bo * 8; pb0 = *(const uint4*)_s; pc0 = *(const uint4*)(_s + 512); } } \
        { const int _t = _tb + bi + 32; pb1 = _z4; pc1 = _z4; if (_t >= 0) { const bf16_t* _s = U + (size_t)(rowbase + _t) * NP + C_X + 2048 + g * 128 + bo * 8; pb1 = *(const uint4*)_s; pc1 = *(const uint4*)(_s + 512); } } \
        pdt = 0.f; if (tid < 64) { const int _t = _tb + tid; if (_t >= 0) pdt = DTb[(size_t)(rowbase + _t) * 32 + h]; } } while (0)
    SSD_PREFETCH(0);
    for (int c = 0; c < nch; ++c) {
        const int tbase = c * 64 - pad;
        *(uint4*)(Xs + xi * 72 + xo * 8) = px; *(uint4*)(Zs + xi * 72 + xo * 8) = pz;
        *(uint4*)(Bs + bi * 136 + bo * 8) = pb0; *(uint4*)(Cs + bi * 136 + bo * 8) = pc0;
        *(uint4*)(Bs + (bi + 32) * 136 + bo * 8) = pb1; *(uint4*)(Cs + (bi + 32) * 136 + bo * 8) = pc1;
        if (tid < 64) { const int t = tbase + tid; const float dt = t >= 0 ? softplusf(pdt + dtb) : 0.f; float x = dt * av;
#pragma unroll
            for (int off = 1; off < 64; off <<= 1) { const float y = __shfl_up(x, off); if (lane >= off) x += y; }
            acum[tid] = x; dtv[tid] = dt; const float xl = __shfl(x, 63); e1[tid] = __expf(xl - x); e2[tid] = __expf(x); }
        if (c + 1 < nch) SSD_PREFETCH(c + 1);
        __syncthreads();
        {
          { const int pp = tid & 63, jq = tid >> 6; float o[8];
#pragma unroll
            for (int e = 0; e < 8; ++e) o[e] = bf2f(Xs[(jq * 8 + e) * 72 + pp]) * dtv[jq * 8 + e];
            *(u32x4*)(XT + pp * 72 + jq * 8) = PACK8(o); }
          { const int n = tid & 127, jq = tid >> 7;
#pragma unroll
            for (int hf = 0; hf < 2; ++hf) { float o[8];
#pragma unroll
                for (int e = 0; e < 8; ++e) { const int j = jq * 16 + hf * 8 + e; o[e] = bf2f(Bs[j * 136 + n]) * e1[j]; }
                *(u32x4*)(BTw + n * 72 + jq * 16 + hf * 8) = PACK8(o); } }
        }
        __syncthreads();
#pragma unroll
        for (int q = 0; q < 2; ++q) { const int tile = 2 * w + q, ti = tile >> 2, tj = tile & 3; f32x4 a4 = (f32x4){0.f, 0.f, 0.f, 0.f};
            if (tj <= ti) {
#pragma unroll
                for (int kk = 0; kk < 4; ++kk) { const bf16x8 a = *(const bf16x8*)(Cs + (ti * 16 + l15) * 136 + kk * 32 + q4 * 8), b = *(const bf16x8*)(Bs + (tj * 16 + l15) * 136 + kk * 32 + q4 * 8); a4 = MFMA16(a, b, a4); } }
#pragma unroll
            for (int jj = 0; jj < 4; ++jj) { const int i = ti * 16 + q4 * 4 + jj, j = tj * 16 + l15; const float v = (j <= i) ? a4[jj] * __expf(acum[i] - acum[j]) : 0.f; Ms[i * 72 + j] = f2bf(v); } }
        { const float cd = e2[63];
#pragma unroll
          for (int pt = 0; pt < 4; ++pt) { hacc[pt] *= cd;
#pragma unroll
              for (int kk = 0; kk < 2; ++kk) { const bf16x8 a = *(const bf16x8*)(XT + (pt * 16 + l15) * 72 + kk * 32 + q4 * 8), b = *(const bf16x8*)(BTw + (w * 16 + l15) * 72 + kk * 32 + q4 * 8); hacc[pt] = MFMA16(a, b, hacc[pt]); } } }
        __syncthreads();
#pragma unroll
        for (int q = 0; q < 2; ++q) { const int tile = 2 * w + q, ti = tile >> 2, tp = tile & 3; f32x4 y4 = (f32x4){0.f, 0.f, 0.f, 0.f};
#pragma unroll
            for (int kk = 0; kk < 4; ++kk) { const bf16x8 a = *(const bf16x8*)(Cs + (ti * 16 + l15) * 136 + kk * 32 + q4 * 8), b = *(const bf16x8*)(Hs + (tp * 16 + l15) * 136 + kk * 32 + q4 * 8); y4 = MFMA16(a, b, y4); }
#pragma unroll
            for (int jj = 0; jj < 4; ++jj) y4[jj] *= e2[ti * 16 + q4 * 4 + jj];
#pragma unroll
            for (int kk = 0; kk < 2; ++kk) { const bf16x8 a = *(const bf16x8*)(Ms + (ti * 16 + l15) * 72 + kk * 32 + q4 * 8), b = *(const bf16x8*)(XT + (tp * 16 + l15) * 72 + kk * 32 + q4 * 8); y4 = MFMA16(a, b, y4); }
#pragma unroll
            for (int jj = 0; jj < 4; ++jj) { const int i = ti * 16 + q4 * 4 + jj, pp = tp * 16 + l15, t = tbase + i;
                const float y = (y4[jj] + bf2f(Xs[i * 72 + pp]) * Dk) * siluf(bf2f(Zs[i * 72 + pp]));
                Ys[i * 72 + pp] = f2bf(y); } }
        __syncthreads();
        { const int row = tid >> 3, oct = tid & 7, t = tbase + row; const uint4 v = *(const uint4*)(Ys + row * 72 + oct * 8); float f[8]; UNPACK8(v, f);
          float sq = (f[0] * f[0] + f[1] * f[1]) + (f[2] * f[2] + f[3] * f[3]) + ((f[4] * f[4] + f[5] * f[5]) + (f[6] * f[6] + f[7] * f[7]));
          sq = red8(sq);
          if (t >= 0) { *(uint4*)(U + (size_t)(rowbase + t) * NP + h * 64 + oct * 8) = v; if (oct == 0) ssqp[rowbase + t] = sq; } }
#pragma unroll
        for (int pt = 0; pt < 4; ++pt)
#pragma unroll
            for (int jj = 0; jj < 4; ++jj) Hs[(pt * 16 + q4 * 4 + jj) * 136 + w * 16 + l15] = f2bf(hacc[pt][jj]);
    }
#pragma unroll
    for (int pt = 0; pt < 4; ++pt)
#pragma unroll
        for (int jj = 0; jj < 4; ++jj) hout[(pt * 16 + q4 * 4 + jj) * 128 + w * 16 + l15] = hacc[pt][jj];
    __syncthreads();
#undef SSD_PREFETCH
}

constexpr int RW_BUF = 5 * 2048 + 1024 + 64 + 1024;
__device__ __forceinline__ void rwkv_stage(const Params& p, int l, int rowbase, int T, int h, int half, const float* __restrict__ shprev, int c, float* buf, int tid) {
    const int tl = tid - 256, tt = tl >> 3, part = tl & 7, t = c * 32 + tt, tcl = t < T ? t : T - 1, m = rowbase + tcl, col = h * 64 + part * 8;
    const bf16_t* U = (const bf16_t*)(p.ws + OFF_U); const bf16_t* LOR = (const bf16_t*)(p.ws + OFF_LOR);
    const bf16_t* ur = U + (size_t)m * NP + C_R + col;
    float decs[8], aas[8]; { const uint4 a = *(const uint4*)(LOR + (size_t)m * NLORA + col), b = *(const uint4*)(LOR + (size_t)m * NLORA + 1024 + col); UNPACK8(a, decs); UNPACK8(b, aas); }
    float r[8], k[8], v[8], pr[8], pk[8], pv[8];
    { const uint4 a = *(const uint4*)ur, b = *(const uint4*)(ur + 1024), cx = *(const uint4*)(ur + 2048); UNPACK8(a, r); UNPACK8(b, k); UNPACK8(cx, v); }
    if (tcl > 0) { const uint4 a = *(const uint4*)(ur - NP), b = *(const uint4*)(ur - NP + 1024), cx = *(const uint4*)(ur - NP + 2048); UNPACK8(a, pr); UNPACK8(b, pk); UNPACK8(cx, pv); }
    else {
#pragma unroll
        for (int e = 0; e < 8; ++e) { pr[e] = shprev ? shprev[col + e] : 0.f; pk[e] = shprev ? shprev[1024 + col + e] : 0.f; pv[e] = shprev ? shprev[2048 + col + e] : 0.f; } }
    const float* mu = p.in[I_MU] + (size_t)l * RC + col;
    float ss = 0.f, c1 = 0.f, c2 = 0.f, bon = 0.f; float nkk[8], wr[8], ww[8], bb[8], km[8];
#pragma unroll
    for (int e = 0; e < 8; ++e) {
        r[e] += (pr[e] - r[e]) * mu[e]; k[e] += (pk[e] - k[e]) * mu[1024 + e]; v[e] += (pv[e] - v[e]) * mu[2048 + e];
        const float dec = __expf(-0.6065306597126334f * decs[e]), aa = aas[e];
        const float kkv = k[e] * p.in[I_KK][l * DM + col + e]; ss += kkv * kkv; nkk[e] = kkv;
        km[e] = k[e] * (1.f + (aa - 1.f) * p.in[I_KA][l * DM + col + e]); bb[e] = aa; ww[e] = dec; wr[e] = dec * r[e];
        c2 += km[e] * r[e]; bon += r[e] * km[e] * p.in[I_RK][l * DM + col + e];
    }
    ss = red8(ss); const float inv = rsqrtf(fmaxf(ss, 1e-24f));
#pragma unroll
    for (int e = 0; e < 8; ++e) { const float kk = nkk[e] * inv; bb[e] *= kk; nkk[e] = -kk; c1 += bb[e] * r[e]; }
    c1 = red8(c1); c2 = red8(c2); bon = red8(bon);
    float* NKK = buf, *WR = buf + 2048, *WW = buf + 4096, *BB = buf + 6144, *KM = buf + 8192, *VV = buf + 10240, *C1 = buf + 11264, *C2 = buf + 11296;
    const int o = tt * 64 + part * 8;
    *(f32x4*)(NKK + o) = (f32x4){nkk[0], nkk[1], nkk[2], nkk[3]}; *(f32x4*)(NKK + o + 4) = (f32x4){nkk[4], nkk[5], nkk[6], nkk[7]};
    *(f32x4*)(WR + o) = (f32x4){wr[0], wr[1], wr[2], wr[3]}; *(f32x4*)(WR + o + 4) = (f32x4){wr[4], wr[5], wr[6], wr[7]};
    *(f32x4*)(WW + o) = (f32x4){ww[0], ww[1], ww[2], ww[3]}; *(f32x4*)(WW + o + 4) = (f32x4){ww[4], ww[5], ww[6], ww[7]};
    *(f32x4*)(BB + o) = (f32x4){bb[0], bb[1], bb[2], bb[3]}; *(f32x4*)(BB + o + 4) = (f32x4){bb[4], bb[5], bb[6], bb[7]};
    *(f32x4*)(KM + o) = (f32x4){km[0], km[1], km[2], km[3]}; *(f32x4*)(KM + o + 4) = (f32x4){km[4], km[5], km[6], km[7]};
    if ((part >> 2) == half) { float* d = VV + tt * 32 + (part & 3) * 8; *(f32x4*)d = (f32x4){v[0], v[1], v[2], v[3]}; *(f32x4*)(d + 4) = (f32x4){v[4], v[5], v[6], v[7]}; }
    if (part == 0) { C1[tt] = c1; C2[tt] = c2; if (half == 0 && t < T) ((float*)(p.ws + OFF_BON))[(size_t)m * 16 + h] = bon; }
}
__device__ __forceinline__ void rwkv_unit(const Params& p, int l, int rowbase, int T, int h, int half, const float* __restrict__ S0, const float* __restrict__ shprev, float* __restrict__ Sout, unsigned char* smem) {
    const int tid = ltid(); float* base = (float*)smem; bf16_t* O = (bf16_t*)(p.ws + OFF_O);
    const int il = tid >> 3, jo = tid & 7;
    f32x2 S2[4];
    if (tid < 256) {
#pragma unroll
        for (int e = 0; e < 4; ++e) { S2[e].x = S0 ? S0[(half * 32 + il) * 64 + jo * 8 + 2 * e] : 0.f; S2[e].y = S0 ? S0[(half * 32 + il) * 64 + jo * 8 + 2 * e + 1] : 0.f; } }
    const int nch = (T + 31) >> 5;
    if (tid >= 256) rwkv_stage(p, l, rowbase, T, h, half, shprev, 0, base, tid);
    __syncthreads();
    for (int c = 0; c < nch; ++c) {
        float* buf = base + (c & 1) * RW_BUF;
        if (tid >= 256) { if (c + 1 < nch) rwkv_stage(p, l, rowbase, T, h, half, shprev, c + 1, base + ((c + 1) & 1) * RW_BUF, tid); }
        else {
            if (c > 0 && tid < 128) { const float* OBp = base + ((c - 1) & 1) * RW_BUF + 11328; const int s = tid >> 2, qq = tid & 3, t = (c - 1) * 32 + s;
                if (t < T) { const f32x4 ov = *(const f32x4*)(OBp + s * 32 + qq * 8), ow = *(const f32x4*)(OBp + s * 32 + qq * 8 + 4); *(u32x4*)(O + (size_t)(rowbase + t) * DM + h * 64 + half * 32 + qq * 8) = (u32x4){pk2(ov[0], ov[1]), pk2(ov[2], ov[3]), pk2(ow[0], ow[1]), pk2(ow[2], ow[3])}; } }
            const float* NKK = buf, *WR = buf + 2048, *WW = buf + 4096, *BB = buf + 6144, *KM = buf + 8192, *VV = buf + 10240, *C1 = buf + 11264, *C2 = buf + 11296; float* OB = buf + 11328;
            const int steps = (T - c * 32) < 32 ? (T - c * 32) : 32;
            __builtin_amdgcn_s_setprio(3);
            for (int s = 0; s < steps; ++s) {
                const int o = s * 64 + jo * 8;
                const f32x4 n0 = *(const f32x4*)(NKK + o), n1 = *(const f32x4*)(NKK + o + 4), r0 = *(const f32x4*)(WR + o), r1 = *(const f32x4*)(WR + o + 4);
                const f32x4 w0 = *(const f32x4*)(WW + o), w1 = *(const f32x4*)(WW + o + 4), b0 = *(const f32x4*)(BB + o), b1 = *(const f32x4*)(BB + o + 4), k0 = *(const f32x4*)(KM + o), k1 = *(const f32x4*)(KM + o + 4);
                const float vi = VV[s * 32 + il], c1 = C1[s], c2 = C2[s];
                f32x2 pa = S2[0] * n0.lo, pb = S2[0] * r0.lo;
                pa = __builtin_elementwise_fma(S2[1], n0.hi, pa); pb = __builtin_elementwise_fma(S2[1], r0.hi, pb);
                pa = __builtin_elementwise_fma(S2[2], n1.lo, pa); pb = __builtin_elementwise_fma(S2[2], r1.lo, pb);
                pa = __builtin_elementwise_fma(S2[3], n1.hi, pa); pb = __builtin_elementwise_fma(S2[3], r1.hi, pb);
                const float sa = red8(pa.x + pa.y), po = red8(pb.x + pb.y);
                const f32x2 sa2 = (f32x2){sa, sa}, vi2 = (f32x2){vi, vi};
                S2[0] = __builtin_elementwise_fma(S2[0], w0.lo, __builtin_elementwise_fma(b0.lo, sa2, k0.lo * vi2));
                S2[1] = __builtin_elementwise_fma(S2[1], w0.hi, __builtin_elementwise_fma(b0.hi, sa2, k0.hi * vi2));
                S2[2] = __builtin_elementwise_fma(S2[2], w1.lo, __builtin_elementwise_fma(b1.lo, sa2, k1.lo * vi2));
                S2[3] = __builtin_elementwise_fma(S2[3], w1.hi, __builtin_elementwise_fma(b1.hi, sa2, k1.hi * vi2));
                OB[s * 32 + il] = fmaf(sa, c1, fmaf(vi, c2, po));
            }
            __builtin_amdgcn_s_setprio(0);
        }
        __syncthreads();
    }
    if (tid < 256) {
        if (tid < 128) { const float* OBp = base + ((nch - 1) & 1) * RW_BUF + 11328; const int s = tid >> 2, qq = tid & 3, t = (nch - 1) * 32 + s;
          if (t < T) { const f32x4 ov = *(const f32x4*)(OBp + s * 32 + qq * 8), ow = *(const f32x4*)(OBp + s * 32 + qq * 8 + 4); *(u32x4*)(O + (size_t)(rowbase + t) * DM + h * 64 + half * 32 + qq * 8) = (u32x4){pk2(ov[0], ov[1]), pk2(ov[2], ov[3]), pk2(ow[0], ow[1]), pk2(ow[2], ow[3])}; } }
#pragma unroll
        for (int e = 0; e < 4; ++e) { Sout[(half * 32 + il) * 64 + jo * 8 + 2 * e] = S2[e].x; Sout[(half * 32 + il) * 64 + jo * 8 + 2 * e + 1] = S2[e].y; }
    }
    __syncthreads();
}

__device__ __forceinline__ void ssd_sample_unit(const Params& p, int l, int s, int hh, unsigned char* smem) {
    const int tid = ltid(), m = MP + s;
    float* xs = (float*)smem;
    float* bc = xs + 1024;
    float* ysq = bc + 512;
    float* yb = ysq + 1024;
    bf16_t* U = (bf16_t*)(p.ws + OFF_U); const float* DTb = (const float*)(p.ws + OFF_DT);
    float* ssqp = (float*)(p.ws + OFF_SSQ);
    const float* pre = p.in[I_SCONV] + ((size_t)l * NS + s) * 3 * CD; bf16_t* ur = U + (size_t)m * NP;
    for (int q = tid; q < 1536; q += 512) {
        int cc; if (q < 1024) cc = hh * 1024 + q; else { const int r = q - 1024, gg = r >> 8, bcs = (r >> 7) & 1, n = r & 127; cc = 2048 + bcs * 512 + (hh * 2 + gg) * 128 + n; }
        const float* cw = p.in[I_CONVW] + (size_t)l * 4 * CD + cc;
        const float v = p.in[I_CONVB][(size_t)l * CD + cc] + cw[0] * pre[cc] + cw[CD] * pre[CD + cc] + cw[2 * CD] * pre[2 * CD + cc] + cw[3 * CD] * bf2f(ur[C_X + cc]);
        const float a = siluf(v); if (q < 1024) xs[q] = a; else bc[q - 1024] = a;
    }
    __syncthreads();
    const int lane32 = tid & 31, prow = tid >> 5;
    f32x4 hnx[4];
    { const float* h00 = p.in[I_SSSM] + (((size_t)l * NS + s) * NH + hh * 16) * 8192;
#pragma unroll
      for (int k = 0; k < 4; ++k) hnx[k] = __builtin_nontemporal_load((const f32x4*)(h00 + (size_t)(k * 512 + tid) * 4)); }
    for (int hi = 0; hi < 16; ++hi) {
        const int h = hh * 16 + hi, gg = hi >> 3;
        const float* h0 = p.in[I_SSSM] + (((size_t)l * NS + s) * NH + h) * 8192; float* ho = p.out + OUT_SSMS + (((size_t)l * NS + s) * NH + h) * 8192;
        f32x4 hv[4];
#pragma unroll
        for (int k = 0; k < 4; ++k) hv[k] = hnx[k];
        if (hi + 1 < 16) {
#pragma unroll
            for (int k = 0; k < 4; ++k) hnx[k] = __builtin_nontemporal_load((const f32x4*)(h0 + 8192 + (size_t)(k * 512 + tid) * 4)); }
        const float dt = softplusf(DTb[(size_t)m * 32 + h] + p.in[I_DTB][l * NH + h]), dA = __expf(-dt * __expf(p.in[I_ALOG][l * NH + h])), Dk = p.in[I_DSKIP][l * NH + h];
        const f32x4 Bv = *(const f32x4*)(bc + gg * 256 + lane32 * 4), Cv = *(const f32x4*)(bc + gg * 256 + 128 + lane32 * 4);
#pragma unroll
        for (int k = 0; k < 4; ++k) { const int pp = k * 16 + prow; const float xv = xs[hi * 64 + pp], xd = xv * dt;
            f32x4 hn = hv[k] * dA + Bv * xd; __builtin_nontemporal_store(hn, (f32x4*)(ho + (size_t)(k * 512 + tid) * 4));
            float y = (hn[0] * Cv[0] + hn[1] * Cv[1]) + (hn[2] * Cv[2] + hn[3] * Cv[3]);
            y += __shfl_xor(y, 1); y += __shfl_xor(y, 2); y += __shfl_xor(y, 4); y += __shfl_xor(y, 8); y += __shfl_xor(y, 16);
            if (lane32 == 0) { const float yo = (y + xv * Dk) * siluf(bf2f(ur[h * 64 + pp])); yb[hi * 64 + pp] = yo; ysq[(hi * 16 + prow) * 4 + k] = yo * yo; } }
    }
    __syncthreads();
    if (tid < 2) { float a = 0.f; for (int i = 0; i < 512; ++i) a += ysq[tid * 512 + i]; const int g0 = (hh * 2 + tid) * 8; ssqp[(size_t)g0 * MT + m] = a;
#pragma unroll
        for (int e = 1; e < 8; ++e) ssqp[(size_t)(g0 + e) * MT + m] = 0.f; }
    if (tid >= 64 && tid < 192) { const int o8 = (tid - 64) * 8; float f[8];
#pragma unroll
        for (int e = 0; e < 8; ++e) f[e] = yb[o8 + e];
        *(u32x4*)(ur + hh * 1024 + o8) = PACK8(f); }
    __syncthreads();
}
__device__ __forceinline__ void rwkv_sample_unit(const Params& p, int l, int s, int hh, unsigned char* smem) {
    const int tid = ltid(), m = MP + s, col = hh * 512 + tid;
    float* NKK = (float*)smem, *WR = NKK + 512, *WW = WR + 512, *BB = WW + 512, *KM = BB + 512, *VV = KM + 512, *C1 = VV + 512, *C2 = C1 + 8; float* OBs = C2 + 8;
    const bf16_t* U = (const bf16_t*)(p.ws + OFF_U); const bf16_t* LOR = (const bf16_t*)(p.ws + OFF_LOR); bf16_t* O = (bf16_t*)(p.ws + OFF_O);
    { const bf16_t* ur = U + (size_t)m * NP + C_R; const float* sh = p.in[I_SSHIFT] + ((size_t)l * NS + s) * RC; const float* mu = p.in[I_MU] + (size_t)l * RC;
      float r = bf2f(ur[col]), k = bf2f(ur[1024 + col]), v = bf2f(ur[2048 + col]);
      r += (sh[col] - r) * mu[col]; k += (sh[1024 + col] - k) * mu[1024 + col]; v += (sh[2048 + col] - v) * mu[2048 + col];
      const float dec = __expf(-0.6065306597126334f * bf2f(LOR[(size_t)m * NLORA + col])), aa = bf2f(LOR[(size_t)m * NLORA + 1024 + col]);
      float kk = k * p.in[I_KK][l * DM + col]; float ss = kk * kk;
#pragma unroll
      for (int o = 1; o < 64; o <<= 1) ss += __shfl_xor(ss, o);
      kk *= rsqrtf(fmaxf(ss, 1e-24f));
      const float km = k * (1.f + (aa - 1.f) * p.in[I_KA][l * DM + col]), bb = kk * aa;
      float c1 = bb * r, c2 = km * r, bon = r * km * p.in[I_RK][l * DM + col];
#pragma unroll
      for (int o = 1; o < 64; o <<= 1) { c1 += __shfl_xor(c1, o); c2 += __shfl_xor(c2, o); bon += __shfl_xor(bon, o); }
      NKK[tid] = -kk; WR[tid] = dec * r; WW[tid] = dec; BB[tid] = bb; KM[tid] = km; VV[tid] = v;
      if ((tid & 63) == 0) { C1[tid >> 6] = c1; C2[tid >> 6] = c2; ((float*)(p.ws + OFF_BON))[(size_t)m * 16 + hh * 8 + (tid >> 6)] = bon; } }
    __syncthreads();
    const int i = tid >> 3, jo = tid & 7;
    for (int hi = 0; hi < 8; ++hi) {
        const int h = hh * 8 + hi; const size_t so = (((size_t)l * NS + s) * 16 + h) * 4096 + i * 64 + jo * 8;
        const f32x4 s0 = __builtin_nontemporal_load((const f32x4*)(p.in[I_SWKV] + so)), s1 = __builtin_nontemporal_load((const f32x4*)(p.in[I_SWKV] + so + 4));
        const int o = hi * 64 + jo * 8;
        const f32x4 n0 = *(const f32x4*)(NKK + o), n1 = *(const f32x4*)(NKK + o + 4), r0 = *(const f32x4*)(WR + o), r1 = *(const f32x4*)(WR + o + 4);
        const f32x4 w0 = *(const f32x4*)(WW + o), w1 = *(const f32x4*)(WW + o + 4), b0 = *(const f32x4*)(BB + o), b1 = *(const f32x4*)(BB + o + 4), k0 = *(const f32x4*)(KM + o), k1 = *(const f32x4*)(KM + o + 4);
        const float vi = VV[hi * 64 + i];
        float psa = 0.f, po = 0.f;
#pragma unroll
        for (int e = 0; e < 4; ++e) { psa += s0[e] * n0[e] + s1[e] * n1[e]; po += s0[e] * r0[e] + s1[e] * r1[e]; }
        const float sa = red8(psa); po = red8(po);
        const f32x4 t0 = s0 * w0 + (b0 * sa + k0 * vi), t1 = s1 * w1 + (b1 * sa + k1 * vi);
        __builtin_nontemporal_store(t0, (f32x4*)(p.out + OUT_WKVS + so)); __builtin_nontemporal_store(t1, (f32x4*)(p.out + OUT_WKVS + so + 4));
        if (jo == 0) OBs[hi * 64 + i] = po + sa * C1[hi] + vi * C2[hi];
    }
    __syncthreads();
    if (tid < 64) { float f[8];
#pragma unroll
        for (int e = 0; e < 8; ++e) f[e] = OBs[tid * 8 + e];
        *(u32x4*)(O + (size_t)m * DM + hh * 512 + tid * 8) = PACK8(f); }
    __syncthreads();
}
__device__ __forceinline__ void scan_phase(const Params& p, int l, unsigned char* smem) {
    const int G = lgdim(), bx = lbid();
#ifndef PROBE_REP_PROMPT
#define PROBE_REP_PROMPT 1
#endif
    for (int rep = 0; rep < PROBE_REP_PROMPT; ++rep) {
    for (int u = bx; u < NB * NH; u += G) { const int b = u >> 5, h = u & 31;
        ssd_unit(p, l, b * LP, h, p.out + OUT_SSMP + (((size_t)l * NB + b) * NH + h) * 8192, smem, rep > 0); }
    for (int u = bx; u < NB * NH; u += G) { const int b = u >> 5, h = (u & 31) >> 1, half = u & 1;
        rwkv_unit(p, l, b * LP, LP, h, half, nullptr, nullptr, p.out + OUT_WKVP + (((size_t)l * NB + b) * 16 + h) * 4096, smem); }
    }
    for (int u = bx; u < NS * 2; u += G) ssd_sample_unit(p, l, u >> 1, u & 1, smem);
    for (int u = bx; u < NS * 2; u += G) rwkv_sample_unit(p, l, u >> 1, u & 1, smem);
}

#define xb_tid ((int)threadIdx.x)
#define XB_TMO      128
#define XB_XCNT(j)  (256  + 64 * (j))
#define XB_XSUB(j)  (1280 + 64 * (j))
#define XB_XGEN(j)  (2304 + 64 * (j))
#define XB_TOP      3328
#define XB_TOPGEN   3392
#define XCD_BAR_WORDS 3456
#define XB_SPIN_CAP (1u << 18)

__device__ __forceinline__ unsigned xb_ld(unsigned* p)              { return __hip_atomic_load(p, __ATOMIC_RELAXED, __HIP_MEMORY_SCOPE_AGENT); }
__device__ __forceinline__ unsigned xb_add(unsigned* p, unsigned v) { return __hip_atomic_fetch_add(p, v, __ATOMIC_RELAXED, __HIP_MEMORY_SCOPE_AGENT); }
__device__ __forceinline__ unsigned xb_xcc_id() { return (unsigned)__builtin_amdgcn_s_getreg((3 << 11) | 20) & 0xFu; }
#define XB_SPIN(cond, bar) do { unsigned _sp = 0; while (cond) { __builtin_amdgcn_s_sleep(1); \
    if ((++_sp & 255u) == 0u) { if (xb_ld(&(bar)[XB_TMO])) break; if (_sp > XB_SPIN_CAP) { atomicAdd(&(bar)[XB_TMO], 1u); break; } } } } while (0)

struct XcdBarrier {
    unsigned* bar; unsigned x;
    volatile LAS unsigned* st;
};

__device__ __forceinline__ XcdBarrier xcd_barrier_post(unsigned* bar, volatile LAS unsigned* st) {
    XcdBarrier b; b.bar = bar; b.x = xb_xcc_id(); b.st = st;
    if (xb_tid == 0) (void)xb_add(&bar[XB_XCNT(b.x)], 1u);
    return b;
}
__device__ __forceinline__ void xcd_barrier_complete(unsigned* bar, unsigned x, unsigned& nloc, unsigned& nx) {
    const unsigned G = gridDim.x * gridDim.y * gridDim.z;
    unsigned sum, cnt, mine, sp = 0u;
    for (;;) {
        sum = 0u; cnt = 0u; mine = 0u;
#pragma unroll
        for (unsigned j = 0; j < 16; ++j) { const unsigned c = xb_ld(&bar[XB_XCNT(j)]); sum += c; cnt += (c > 0u) ? 1u : 0u; mine = (j == x) ? c : mine; }
        if (sum == G) break;
        __builtin_amdgcn_s_sleep(1);
        if ((++sp & 255u) == 0u) { if (xb_ld(&bar[XB_TMO])) break; if (sp > XB_SPIN_CAP) { atomicAdd(&bar[XB_TMO], 1u); break; } }
    }
    nloc = mine > 0u ? mine : 1u; nx = cnt > 0u ? cnt : 1u;
}

__device__ __forceinline__ void xcd_barrier(const XcdBarrier& b) {
    asm volatile("s_waitcnt vmcnt(0)" ::: "memory");
    __syncthreads();
    if (xb_tid == 0) {
        unsigned* bar = b.bar;
        __builtin_amdgcn_s_waitcnt(0);
        unsigned nloc = b.st[0], nx = b.st[1];
        if (nloc == 0u) { xcd_barrier_complete(bar, b.x, nloc, nx); b.st[0] = nloc; b.st[1] = nx; }
        const unsigned old = xb_add(&bar[XB_XSUB(b.x)], 1u);
        const unsigned gen = old / nloc;
        if (old + 1u == (gen + 1u) * nloc) {
            __builtin_amdgcn_fence(__ATOMIC_RELEASE, "agent");
            asm volatile("s_waitcnt vmcnt(0)" ::: "memory");
            const unsigned og = xb_add(&bar[XB_TOP], 1u);
            const unsigned tg = og / nx;
            if (og + 1u == (tg + 1u) * nx) xb_add(&bar[XB_TOPGEN], 1u);
            else XB_SPIN(xb_ld(&bar[XB_TOPGEN]) == tg, bar);
            __builtin_amdgcn_fence(__ATOMIC_ACQUIRE, "agent");
            xb_add(&bar[XB_XGEN(b.x)], 1u);
            asm volatile("s_waitcnt vmcnt(0)" ::: "memory");
        } else {
            XB_SPIN(xb_ld(&bar[XB_XGEN(b.x)]) == gen, bar);
            __builtin_amdgcn_fence(__ATOMIC_ACQUIRE, "agent");
            asm volatile("s_waitcnt vmcnt(0)" ::: "memory");
        }
    }
    __syncthreads();
}


__device__ __forceinline__ void conv_phase(const Params& p, int l, const XcdBarrier& xbar) {
    const int tid = ltid(); const bool act = tid < 384; bf16_t* U = (bf16_t*)(p.ws + OFF_U);
    const int cc = (act ? tid : 0) * 8, G = lgdim(), w = lbid(), NBLK = MP / 8, rb0 = (int)((long)w * NBLK / G), rb1 = (int)((long)(w + 1) * NBLK / G);
    float cw[4][8], cb[8], w0[8], w1[8], w2[8];
#pragma unroll
    for (int k = 0; k < 4; ++k) { const float* sp = p.in[I_CONVW] + ((size_t)l * 4 + k) * CD + cc; const f32x4 a = *(const f32x4*)sp, b = *(const f32x4*)(sp + 4);
#pragma unroll
        for (int e = 0; e < 4; ++e) { cw[k][e] = a[e]; cw[k][4 + e] = b[e]; } }
    { const float* sp = p.in[I_CONVB] + (size_t)l * CD + cc; const f32x4 a = *(const f32x4*)sp, b = *(const f32x4*)(sp + 4);
#pragma unroll
      for (int e = 0; e < 4; ++e) { cb[e] = a[e]; cb[4 + e] = b[e]; } }
#define CV_LOAD(tt, mm, dst) do { if ((tt) >= 0) { const uint4 _v = *(const uint4*)(U + (size_t)(mm) * NP + C_X + cc); UNPACK8(_v, dst); } else { dst[0] = dst[1] = dst[2] = dst[3] = dst[4] = dst[5] = dst[6] = dst[7] = 0.f; } } while (0)
    { const int m0 = rb0 * 8, t0 = m0 % LP; CV_LOAD(t0 - 3, m0 - 3, w0); CV_LOAD(t0 - 2, m0 - 2, w1); CV_LOAD(t0 - 1, m0 - 1, w2); }
    asm volatile("s_waitcnt vmcnt(0)" ::: "memory");
    xcd_barrier(xbar);
    if (act) {
        for (int rb = rb0; rb < rb1; ++rb) {
            const int m0 = rb * 8;
            if (m0 % LP == 0) {
#pragma unroll
                for (int e = 0; e < 8; ++e) { w0[e] = 0.f; w1[e] = 0.f; w2[e] = 0.f; } }
            uint4 raw[8];
#pragma unroll
            for (int ii = 0; ii < 8; ++ii) raw[ii] = *(const uint4*)(U + (size_t)(m0 + ii) * NP + C_X + cc);
            asm volatile("s_waitcnt vmcnt(0)" ::: "memory");
#pragma unroll
            for (int ii = 0; ii < 8; ++ii) { float cur[8], o[8]; UNPACK8(raw[ii], cur);
#pragma unroll
                for (int e = 0; e < 8; ++e) { o[e] = siluf(cb[e] + cw[0][e] * w0[e] + cw[1][e] * w1[e] + cw[2][e] * w2[e] + cw[3][e] * cur[e]); w0[e] = w1[e]; w1[e] = w2[e]; w2[e] = cur[e]; }
                *(u32x4*)(U + (size_t)(m0 + ii) * NP + C_X + cc) = PACK8(o); }
        }
    }
#undef CV_LOAD
}
#ifndef PROBE_REP_GEMM
#define PROBE_REP_GEMM 1
#endif
constexpr int LDS_BYTES = 131072 + 16;
__global__ void __launch_bounds__(512) mega(Params p, int ph_lo, int ph_hi) {
    extern __shared__ __attribute__((aligned(16))) unsigned char smem[];
    cg::grid_group grid = cg::this_grid();
    LAS unsigned char* lds = (LAS unsigned char*)smem;
    unsigned char* ws = p.ws;
#define G lgdim()
#define bx lbid()
    bf16_t* U = (bf16_t*)(ws + OFF_U); bf16_t* Tb = (bf16_t*)(ws + OFF_T);
    if (threadIdx.x < 4) ((LAS unsigned*)(lds + 131072))[threadIdx.x] = 0u;
    __syncthreads();
    XcdBarrier xbar = xcd_barrier_post((unsigned*)(ws + OFF_BAR), (volatile LAS unsigned*)(lds + 131072));
    int ph = 0;
#ifndef PHMASK
#define PHMASK 0xFFF
#endif
#define PHASE_BEGIN(k) if (((PHMASK >> (k)) & 1) && ph >= ph_lo && ph < ph_hi) {
#define PHASE_END   if (ph + 1 < ph_hi) { if (ph == 0) grid.sync(); else xcd_barrier(xbar); } } ++ph;
    PHASE_BEGIN(0) phase0(p, smem); PHASE_END
    for (int l = 0; l < 2; ++l) {
        unsigned char* wl = ws + (size_t)l * W_STRIDE;
        const bf16_t* Xbin = (const bf16_t*)(ws + OFF_XB);
        PHASE_BEGIN(1) { pg8::Gemm g{Xbin, (const bf16_t*)(wl + W_IN), MT, NP, DM, DM}; pg8::StaticOrder S; S.init(MT, NP, G, bx); EpiU E{U, (float*)(ws + OFF_DT)}; for (int rep = 0; rep < PROBE_REP_GEMM; ++rep) pg8::gemm_phase(lds, g, S, E); } PHASE_END
        PHASE_BEGIN(2) prep_phase(p, l); conv_phase(p, l, xbar);
                         { int kl = KLORA; asm volatile("" : "+s"(kl)); pg8::Gemm g{(const bf16_t*)(ws + OFF_AP), (const bf16_t*)(wl + W_LR), MT, NLORA, kl, kl}; pg8::StaticOrder S; S.init(MT, NLORA, G, bx);
                      EpiLora E{(bf16_t*)(ws + OFF_LOR), p.in[I_W0] + (size_t)l * DM, p.in[I_A0] + (size_t)l * DM}; for (int rep = 0; rep < PROBE_REP_GEMM; ++rep) pg8::gemm_phase(lds, g, S, E); } PHASE_END
        PHASE_BEGIN(4) scan_phase(p, l, smem); PHASE_END
        PHASE_BEGIN(5) post_phase(p, l); PHASE_END
        PHASE_BEGIN(6) { pg8::StaticOrder S; S.init(MTAIL0, DM, G, bx);
                      { pg8::Gemm g{U, (const bf16_t*)(wl + W_PS), MTAIL0, DM, DI, NP}; EpiMerge<0> E{Tb, nullptr, U}; for (int rep = 0; rep < PROBE_REP_GEMM; ++rep) { pg8::gemm_phase(lds, g, S, E); gemm_tail(g.A, g.lda, g.Bt, DI, E, smem); } }
                      { pg8::Gemm g{U + C_R, (const bf16_t*)(wl + W_PR), MTAIL0, DM, DM, NP}; EpiMerge<1> E{Tb, (bf16_t*)(ws + OFF_MG), U}; for (int rep = 0; rep < PROBE_REP_GEMM; ++rep) { pg8::gemm_phase(lds, g, S, E); gemm_tail(g.A, g.lda, g.Bt, DM, E, smem); } } } PHASE_END
        PHASE_BEGIN(7) { pg8::Gemm g{(const bf16_t*)(ws + OFF_MG), (const bf16_t*)(wl + W_WO), MTAIL0, DM, DM, DM}; pg8::StaticOrder S; S.init(MTAIL0, DM, G, bx); EpiResid E{Tb, Xbin}; for (int rep = 0; rep < PROBE_REP_GEMM; ++rep) { pg8::gemm_phase(lds, g, S, E); gemm_tail(g.A, g.lda, g.Bt, DM, E, smem); } } PHASE_END
        PHASE_BEGIN(8) ln_phase(p, Tb, p.in[I_LN1G] + (size_t)l * DM, p.in[I_LN1B] + (size_t)l * DM, (bf16_t*)(ws + OFF_X1B), false); PHASE_END
        PHASE_BEGIN(9) { pg8::Gemm g{(const bf16_t*)(ws + OFF_X1B), (const bf16_t*)(wl + W_FI), MT, 2 * DFF, DM, DM}; pg8::StaticOrder S; S.init(MT, 2 * DFF, G, bx); EpiSwiglu E{(bf16_t*)(ws + OFF_ACT)}; for (int rep = 0; rep < PROBE_REP_GEMM; ++rep) pg8::gemm_phase(lds, g, S, E); } PHASE_END
        PHASE_BEGIN(10) { pg8::Gemm g{(const bf16_t*)(ws + OFF_ACT), (const bf16_t*)(wl + W_FO), MTAIL0, DM, DFF, DFF}; pg8::StaticOrder S; S.init(MTAIL0, DM, G, bx); EpiResid E{Tb, (const bf16_t*)(ws + OFF_X1B)}; for (int rep = 0; rep < PROBE_REP_GEMM; ++rep) { pg8::gemm_phase(lds, g, S, E); gemm_tail(g.A, g.lda, g.Bt, DFF, E, smem); } } PHASE_END
        PHASE_BEGIN(11) ln_phase(p, Tb, p.in[I_LN2G] + (size_t)l * DM, p.in[I_LN2B] + (size_t)l * DM, (bf16_t*)(ws + OFF_XB), l == 1); PHASE_END
    }
}
#undef G
#undef bx
constexpr int N_PHASES = 21;

extern "C" void kernel_launch(void* const* d_in, const int* in_sizes, int n_in, void* d_out, int out_size, void* d_ws, size_t ws_size, hipStream_t stream) {
    static int grid_blocks = 0;
    if (!grid_blocks) {
        int dev = 0, cus = 0, per_cu = 0;
        hipGetDevice(&dev); hipDeviceGetAttribute(&cus, hipDeviceAttributeMultiprocessorCount, dev);
        hipFuncSetAttribute((const void*)mega, hipFuncAttributeMaxDynamicSharedMemorySize, LDS_BYTES);
        hipOccupancyMaxActiveBlocksPerMultiprocessor(&per_cu, (const void*)mega, 512, LDS_BYTES);
        if (per_cu < 1) per_cu = 1;
        grid_blocks = cus * per_cu;
        if (ws_size < 947 * MiB) fprintf(stderr, "kernel_launch: workspace too small: %zu\n", ws_size);
    }
    hipMemsetAsync((char*)d_ws + OFF_BAR, 0, XCD_BAR_WORDS * 4, stream);
    Params p{};
    for (int i = 0; i < N_IN; ++i) p.in[i] = (const float*)d_in[i];
    p.out = (float*)d_out; p.ws = (unsigned char*)d_ws;
    int lo = 0, hi = N_PHASES;
    void* args[] = {&p, &lo, &hi};
    hipError_t e = hipLaunchCooperativeKernel((const void*)mega, dim3(grid_blocks), dim3(512), args, LDS_BYTES, stream);
    if (e != hipSuccess) fprintf(stderr, "cooperative launch failed: %s (grid %d)\n", hipGetErrorString(e), grid_blocks);
}
```
